# Optimizing an MI355X kernel written in HIP

```python
import jax, jax.numpy as jnp
from jax import lax
import numpy as np

D_MODEL = 1024
BATCH = 32
SEQ = 2048
DEPTH = 2

HEAD_DIM = D_MODEL // 16
ATTN_HEADS = 6
ATTN_WIDTH = ATTN_HEADS * HEAD_DIM
ATTN_PATTERNS = ((128, 1), (512, 4), (2048, 16))
HEADS_PER_PATTERN = ATTN_HEADS // len(ATTN_PATTERNS)
CONV_GROUPS = 4
CONV_WIDTH = CONV_GROUPS * HEAD_DIM
CONV_TAPS = 31
LRU_HEADS = 6
LRU_WIDTH = LRU_HEADS * HEAD_DIM
LRU_CONV_TAPS = 4
LRU_C = 8.0
MIX_WIDTH = ATTN_WIDTH + CONV_WIDTH + LRU_WIDTH
D_FF = 4 * D_MODEL
RMS_EPS = 1e-6
LN_EPS = 1e-5

Q0 = 0
K0 = Q0 + ATTN_WIDTH
V0 = K0 + ATTN_WIDTH
CA0 = V0 + ATTN_WIDTH
CG0 = CA0 + CONV_WIDTH
LG0 = CG0 + CONV_WIDTH
LX0 = LG0 + LRU_WIDTH
IN_COLS = LX0 + LRU_WIDTH

kernel_name = "hymba_style_conv_dilattn_rglru_block"


def rmsnorm(x, g):
    xf = x.astype(jnp.float32)
    y = xf * lax.rsqrt(jnp.mean(xf * xf, axis=-1, keepdims=True) + RMS_EPS)
    return y.astype(x.dtype) * g


def layernorm(x, g, b):
    xf = x.astype(jnp.float32)
    mu = jnp.mean(xf, axis=-1, keepdims=True)
    var = jnp.mean(jnp.square(xf - mu), axis=-1, keepdims=True)
    y = (xf - mu) * lax.rsqrt(var + LN_EPS)
    return y.astype(x.dtype) * g + b


def alibi_slopes(n):
    return jnp.asarray(2.0 ** (-8.0 * np.arange(1, n + 1) / n), dtype=jnp.float32)


def causal_depthwise_conv(x, w, b):
    K, C = w.shape
    y = lax.conv_general_dilated(x, w[:, None, :], window_strides=(1,), padding=[(K - 1, 0)],
                                 dimension_numbers=("NWC", "WIO", "NWC"), feature_group_count=C)
    return y + b


def dilated_window_attention(q, k, v, slopes, window, dilation):
    B, S, H, Dh = q.shape
    W = window // dilation
    L = S // dilation
    nb = -(-L // W)
    Lp = nb * W

    def to_blocks(t):
        t = t.reshape(B, L, dilation, H, Dh).transpose(0, 2, 3, 1, 4)
        t = jnp.pad(t, ((0, 0), (0, 0), (0, 0), (0, Lp - L), (0, 0)))
        return t.reshape(B, dilation, H, nb, W, Dh)

    def with_prev(t):
        prev = jnp.pad(t, ((0, 0), (0, 0), (0, 0), (1, 0), (0, 0), (0, 0)))[:, :, :, :-1]
        return jnp.concatenate([prev, t], axis=4)

    qb = to_blocks(q)
    kb = with_prev(to_blocks(k))
    vb = with_prev(to_blocks(v))
    s = jnp.einsum("brhnqc,brhnkc->brhnqk", qb, kb).astype(jnp.float32) * (Dh ** -0.5)
    qi = jnp.arange(W)[:, None]
    kj = jnp.arange(2 * W)[None, :]
    dist = qi + W - kj
    band = (dist >= 0) & (dist <= W)
    has_prev = (jnp.arange(nb)[:, None, None] > 0) | (kj[None] >= W)
    valid = band[None] & has_prev
    bias = -slopes[:, None, None] * (dilation * dist).astype(jnp.float32)[None]
    s = jnp.where(valid[None, None, None], s + bias[None, None, :, None], -jnp.inf)
    m = jnp.max(s, axis=-1, keepdims=True)
    p = jnp.exp(s - m)
    l = jnp.sum(p, axis=-1, keepdims=True)
    o = jnp.einsum("brhnqk,brhnkc->brhnqc", p, vb.astype(jnp.float32)) / l
    lse = (m + jnp.log(l))[..., 0]
    o = o.reshape(B, dilation, H, Lp, Dh)[:, :, :, :L].transpose(0, 3, 1, 2, 4).reshape(B, S, H, Dh)
    lse = lse.reshape(B, dilation, H, Lp)[..., :L].transpose(0, 3, 1, 2).reshape(B, S, H)
    return o, lse


def attention_mixer(q, k, v):
    B, S = q.shape[:2]
    slopes = alibi_slopes(ATTN_HEADS)
    outs, lses = [], []
    for g, (window, dilation) in enumerate(ATTN_PATTERNS):
        sl = slice(g * HEADS_PER_PATTERN, (g + 1) * HEADS_PER_PATTERN)
        o, lse = dilated_window_attention(q[:, :, sl], k[:, :, sl], v[:, :, sl], slopes[sl], window, dilation)
        outs.append(o)
        lses.append(lse)
    o = jnp.stack(outs, axis=2)
    lse = jnp.stack(lses, axis=2)
    alpha = jax.nn.softmax(lse, axis=2)
    return (o * alpha[..., None]).reshape(B, S, ATTN_WIDTH).astype(q.dtype)


def conv_module(a, gate, dw_w, dw_b, ln_g, ln_b):
    u = a * jax.nn.sigmoid(gate)
    u = causal_depthwise_conv(u, dw_w, dw_b)
    u = layernorm(u, ln_g, ln_b)
    return jax.nn.silu(u)


def rg_lru(x, w_a, b_a, w_x, b_x, lam):
    B, S, C = x.shape
    xh = x.reshape(B, S, LRU_HEADS, C // LRU_HEADS)
    r = jax.nn.sigmoid(jnp.einsum("bshi,hio->bsho", xh, w_a).reshape(B, S, C) + b_a)
    i = jax.nn.sigmoid(jnp.einsum("bshi,hio->bsho", xh, w_x).reshape(B, S, C) + b_x)
    log_a = -LRU_C * r.astype(jnp.float32) * jax.nn.softplus(-lam.astype(jnp.float32))
    a = jnp.exp(log_a)
    b = jnp.sqrt(-jnp.expm1(2.0 * log_a)) * (i * x).astype(jnp.float32)

    def combine(left, right):
        a1, b1 = left
        a2, b2 = right
        return a1 * a2, a2 * b1 + b2

    _, h = lax.associative_scan(combine, (a, b), axis=1)
    return h.astype(x.dtype)


def recurrent_mixer(gate, xr, cw, cb, w_a, b_a, w_x, b_x, lam):
    u = causal_depthwise_conv(xr, cw, cb)
    return jax.nn.gelu(gate) * rg_lru(u, w_a, b_a, w_x, b_x, lam)


def hybrid_layer(x, norm1_g, w_in, conv_dw_w, conv_dw_b, conv_ln_g, conv_ln_b,
                 lru_conv_w, lru_conv_b, lru_wa, lru_ba, lru_wx, lru_bx, lru_lambda,
                 w_out, norm2_g, w_up, w_down):
    B, S, _ = x.shape
    h = rmsnorm(x, norm1_g)
    z = jnp.einsum("bsd,dc->bsc", h, w_in)
    q = z[..., Q0:K0].reshape(B, S, ATTN_HEADS, HEAD_DIM)
    k = z[..., K0:V0].reshape(B, S, ATTN_HEADS, HEAD_DIM)
    v = z[..., V0:CA0].reshape(B, S, ATTN_HEADS, HEAD_DIM)
    y_attn = attention_mixer(q, k, v)
    y_conv = conv_module(z[..., CA0:CG0], z[..., CG0:LG0], conv_dw_w, conv_dw_b, conv_ln_g, conv_ln_b)
    y_lru = recurrent_mixer(z[..., LG0:LX0], z[..., LX0:IN_COLS], lru_conv_w, lru_conv_b,
                            lru_wa, lru_ba, lru_wx, lru_bx, lru_lambda)
    mix = jnp.concatenate([y_attn, y_conv, y_lru], axis=-1)
    x = x + jnp.einsum("bsc,cd->bsd", mix, w_out)
    h2 = rmsnorm(x, norm2_g)
    ff = jnp.square(jax.nn.relu(jnp.einsum("bsd,df->bsf", h2, w_up)))
    return x + jnp.einsum("bsf,fd->bsd", ff, w_down)


def setup_inputs(seed: int = 0) -> dict:
    key = jax.random.key(seed)
    ks = jax.random.split(key, 20)
    n = jax.random.normal
    f32 = jnp.float32
    x = n(ks[0], (BATCH, SEQ, D_MODEL), f32)
    norm1_g = 1.0 + 0.02 * n(ks[1], (DEPTH, D_MODEL), f32)
    w_in = n(ks[2], (DEPTH, D_MODEL, IN_COLS), f32) * D_MODEL ** -0.5
    conv_dw_w = n(ks[3], (DEPTH, CONV_TAPS, CONV_WIDTH), f32) * CONV_TAPS ** -0.5
    conv_dw_b = 0.02 * n(ks[4], (DEPTH, CONV_WIDTH), f32)
    conv_ln_g = 1.0 + 0.02 * n(ks[5], (DEPTH, CONV_WIDTH), f32)
    conv_ln_b = 0.02 * n(ks[6], (DEPTH, CONV_WIDTH), f32)
    lru_conv_w = n(ks[7], (DEPTH, LRU_CONV_TAPS, LRU_WIDTH), f32) * LRU_CONV_TAPS ** -0.5
    lru_conv_b = 0.02 * n(ks[8], (DEPTH, LRU_WIDTH), f32)
    blk = LRU_WIDTH // LRU_HEADS
    lru_wa = n(ks[9], (DEPTH, LRU_HEADS, blk, blk), f32) * blk ** -0.5
    lru_ba = 0.02 * n(ks[10], (DEPTH, LRU_WIDTH), f32)
    lru_wx = n(ks[11], (DEPTH, LRU_HEADS, blk, blk), f32) * blk ** -0.5
    lru_bx = 0.02 * n(ks[12], (DEPTH, LRU_WIDTH), f32)
    a_c = jax.random.uniform(ks[13], (DEPTH, LRU_WIDTH), f32, 0.9, 0.999)
    a0 = a_c ** (1.0 / LRU_C)
    lru_lambda = jnp.log(a0) - jnp.log1p(-a0)
    w_out = n(ks[14], (DEPTH, MIX_WIDTH, D_MODEL), f32) * MIX_WIDTH ** -0.5
    norm2_g = 1.0 + 0.02 * n(ks[15], (DEPTH, D_MODEL), f32)
    w_up = n(ks[16], (DEPTH, D_MODEL, D_FF), f32) * D_MODEL ** -0.5
    w_down = n(ks[17], (DEPTH, D_FF, D_MODEL), f32) * D_FF ** -0.5
    final_g = 1.0 + 0.02 * n(ks[18], (D_MODEL,), f32)
    return {"x": x, "norm1_g": norm1_g, "w_in": w_in, "conv_dw_w": conv_dw_w, "conv_dw_b": conv_dw_b,
            "conv_ln_g": conv_ln_g, "conv_ln_b": conv_ln_b, "lru_conv_w": lru_conv_w, "lru_conv_b": lru_conv_b,
            "lru_wa": lru_wa, "lru_ba": lru_ba, "lru_wx": lru_wx, "lru_bx": lru_bx, "lru_lambda": lru_lambda,
            "w_out": w_out, "norm2_g": norm2_g, "w_up": w_up, "w_down": w_down, "final_g": final_g}


def reference(x, norm1_g, w_in, conv_dw_w, conv_dw_b, conv_ln_g, conv_ln_b, lru_conv_w, lru_conv_b,
              lru_wa, lru_ba, lru_wx, lru_bx, lru_lambda, w_out, norm2_g, w_up, w_down, final_g):
    for l in range(DEPTH):
        x = hybrid_layer(x, norm1_g[l], w_in[l], conv_dw_w[l], conv_dw_b[l], conv_ln_g[l], conv_ln_b[l],
                         lru_conv_w[l], lru_conv_b[l], lru_wa[l], lru_ba[l], lru_wx[l], lru_bx[l], lru_lambda[l],
                         w_out[l], norm2_g[l], w_up[l], w_down[l])
    return rmsnorm(x, final_g)
```

```cpp
#include <hip/hip_runtime.h>
#include <hip/hip_cooperative_groups.h>
#include <cstdio>
#include <cstdint>
namespace cg = cooperative_groups;

#ifndef ONE_LAUNCH
#define ONE_LAUNCH 1
#endif

#define LAS __attribute__((address_space(3)))
typedef unsigned short bf16_t;
typedef short bf16x8 __attribute__((ext_vector_type(8)));
typedef float f32x4 __attribute__((ext_vector_type(4)));
typedef float f32x2 __attribute__((ext_vector_type(2)));
typedef unsigned u32x4 __attribute__((ext_vector_type(4)));
typedef unsigned u32x2 __attribute__((ext_vector_type(2)));
typedef short v4i16_t __attribute__((ext_vector_type(4)));
typedef unsigned long long u64;

constexpr int DM = 1024, BATCH = 32, SEQ = 2048, M = BATCH * SEQ;
constexpr int HD = 64, AW = 384, CW = 256, LW = 384, INC = 2432, INP = 2560, FF = 4096;
constexpr int Q0 = 0, K0 = 384, V0 = 768, CA0 = 1152, CG0 = 1408, LG0 = 1664, LX0 = 2048;
constexpr float RMS_EPS = 1e-6f, LN_EPS = 1e-5f;
constexpr float LOG2E = 1.4426950408889634f, LN2 = 0.6931471805599453f;

constexpr size_t MiB = 1u << 20;
constexpr size_t WS_CTR = 0, WS_BAR = 65536;
constexpr size_t WS_CTR_UNUSED = 0;
constexpr size_t WS_W = 2 * MiB, W_LAYER = 23 * MiB;
constexpr size_t WO_IN = 0, WO_OUT = 5 * MiB, WO_UP = 7 * MiB, WO_DN = 15 * MiB;
constexpr size_t WS_SSQ = 48 * MiB;
constexpr size_t WS_LSE = 51 * MiB;
constexpr size_t WS_XB = 53 * MiB;
constexpr size_t WS_BIG = 181 * MiB;
constexpr size_t WS_Z = WS_BIG, WS_MIX = WS_BIG + 304 * MiB, WS_AO = WS_BIG + 432 * MiB;
constexpr size_t WS_Y2 = WS_BIG + 480 * MiB, WS_SUM = WS_BIG + 528 * MiB;
constexpr size_t WS_WTG = 1 * MiB;
constexpr size_t WS_END = WS_BIG + 530 * MiB;
constexpr int N_LRUC = 6 * BATCH * 16, N_ATT = BATCH * 96;

constexpr int LDS_BYTES = 147456;
constexpr int MISC_OFF = 131072;

__device__ __forceinline__ float bf_lo(unsigned w) { return __uint_as_float(w << 16); }
__device__ __forceinline__ float bf_hi(unsigned w) { return __uint_as_float(w & 0xffff0000u); }
__device__ __forceinline__ float bf2f(bf16_t b) { return __uint_as_float((unsigned)b << 16); }
__device__ __forceinline__ unsigned f2bf(float f) { unsigned u = __float_as_uint(f); return (u + 0x7fffu + ((u >> 16) & 1u)) >> 16; }
__device__ __forceinline__ unsigned pk2(float lo, float hi) { return f2bf(lo) | (f2bf(hi) << 16); }
__device__ __forceinline__ unsigned cvt_pk_bf16(float lo, float hi) { unsigned r; asm volatile("v_cvt_pk_bf16_f32 %0, %1, %2" : "=v"(r) : "v"(lo), "v"(hi)); return r; }
__device__ __forceinline__ float sigmoidf_(float x) { return __builtin_amdgcn_rcpf(1.f + __expf(-x)); }
__device__ __forceinline__ float wave_sum(float v) {
#pragma unroll
    for (int o = 1; o < 64; o <<= 1) v += __shfl_xor(v, o);
    return v;
}
__device__ __forceinline__ float rinv_from(u64 v) { return rsqrtf((float)v * (1.0f / 16777216.0f) * (1.0f / 1024.0f) + RMS_EPS); }

namespace pg8 {
constexpr int BM = 256, BK = 64, HALF = 128, HTB = HALF * BK * 2, STAGE_BYTES = 8 * HTB, NXCD = 8, WGM = 8;
__host__ __device__ __forceinline__ int lds_byte(int r, int c) { const int st = (r >> 4) * 2 + (c >> 5), rr = r & 15, cc = c & 31, ob = rr * 64 + cc * 2; return st * 1024 + (ob ^ (((ob >> 9) & 1) << 5)); }
__host__ __device__ __forceinline__ void stage_rc(int b, int& R, int& C) { const int st = b / 1024, sb = b % 1024, swz = sb ^ (((sb >> 9) & 1) << 5); R = (st >> 1) * 16 + swz / 64; C = (st & 1) * 32 + (swz % 64) / 2; }
__host__ __device__ __forceinline__ int perm32(int rho) { const int n = rho >> 4, i = rho & 15; return 8 * (i >> 2) + 4 * n + (i & 3); }

struct Unit { int pm, pn; };
struct Gemm { const bf16_t* A; const bf16_t* Bt; int M, N, K; };

struct StaticOrder {
    int nM, nN, nwg, G, c;
    __host__ __device__ void init(int M_, int N_, int G_, int c_) { nM = M_ / BM; nN = N_ / BM; nwg = nM * nN; G = G_; c = c_; }
    __host__ __device__ bool next(int i, Unit& u) const {
        const long L = (long)i * G + c; if (L >= nwg) return false;
        int wgid = (int)L; { const int q = nwg / NXCD, r = nwg % NXCD, xcd = wgid % NXCD, off = wgid / NXCD; wgid = (xcd < r ? xcd * (q + 1) : r * (q + 1) + (xcd - r) * q) + off; }
        const int nig = WGM * nN, gid = wgid / nig, fm = gid * WGM, gsz = (nM - fm) < WGM ? (nM - fm) : WGM;
        u.pm = fm + ((wgid % nig) % gsz); u.pn = (wgid % nig) / gsz; return true;
    }
    __device__ __forceinline__ void a_ready(const Unit&) const {}
    __device__ __forceinline__ void done(const Unit&) const {}
};

template <int ACT> struct EpiRowScale {
    static constexpr bool PERM = true, AFTER_DRAIN = false;
    bf16_t* O; int ldc; const u64* ssq; int nvalid;
    __device__ __forceinline__ void operator()(const f32x4 (&acc)[2][2][4][2], const Unit& u, int wr, int wc, int fr, int fq) const {
        const int row0 = u.pm * BM + wr * 64 + fr; const int col0 = u.pn * BM + wc * 32 + 8 * fq;
        float rs[2][4];
        { const int ln = fr + 16 * fq; float rl[2];
#pragma unroll
          for (int ai = 0; ai < 2; ++ai) rl[ai] = rinv_from(ssq[u.pm * BM + ai * HALF + wr * 64 + ln]);
#pragma unroll
          for (int ai = 0; ai < 2; ++ai)
#pragma unroll
              for (int m = 0; m < 4; ++m) rs[ai][m] = __shfl(rl[ai], 16 * m + fr); }
        const bool two = (u.pn * BM + HALF < nvalid);
#pragma unroll
        for (int ai = 0; ai < 2; ++ai)
#pragma unroll
            for (int m = 0; m < 4; ++m) {
                const int row = row0 + ai * HALF + m * 16; const float s = rs[ai][m];
                bf16_t* rowp = O + (size_t)row * ldc + col0;
#pragma unroll
                for (int bj = 0; bj < 2; ++bj) {
                    if (bj == 0 || two) {
                        f32x4 v0 = acc[ai][bj][m][0] * s, v1 = acc[ai][bj][m][1] * s;
                        if (ACT == 1) {
#pragma unroll
                            for (int e = 0; e < 4; ++e) { float a = fmaxf(v0[e], 0.f), b = fmaxf(v1[e], 0.f); v0[e] = a * a; v1[e] = b * b; }
                        }
                        u32x4 w; w.x = cvt_pk_bf16(v0[0], v0[1]); w.y = cvt_pk_bf16(v0[2], v0[3]); w.z = cvt_pk_bf16(v1[0], v1[1]); w.w = cvt_pk_bf16(v1[2], v1[3]);
                        __builtin_nontemporal_store(w, (u32x4*)(rowp + bj * HALF));
                    }
                }
            }
    }
};
struct EpiResid {
    static constexpr bool PERM = true, AFTER_DRAIN = false;
    bf16_t* xb; u64* ssq;
    __device__ __forceinline__ void operator()(const f32x4 (&acc)[2][2][4][2], const Unit& u, int wr, int wc, int fr, int fq) const {
        const int col0 = u.pn * BM + wc * 32 + 8 * fq;
#pragma unroll
        for (int ai = 0; ai < 2; ++ai) {
            u32x4 bs[4][2]; float qs[4];
#pragma unroll
            for (int m = 0; m < 4; ++m) { const size_t off = (size_t)(u.pm * BM + ai * HALF + wr * 64 + m * 16 + fr) * DM + col0;
#pragma unroll
                for (int bj = 0; bj < 2; ++bj) bs[m][bj] = *(const u32x4*)(xb + off + bj * HALF); }
#pragma unroll
            for (int m = 0; m < 4; ++m) {
                const int row = u.pm * BM + ai * HALF + wr * 64 + m * 16 + fr; const size_t off = (size_t)row * DM + col0; float q = 0.f;
#pragma unroll
                for (int bj = 0; bj < 2; ++bj) {
                    const f32x4 a0 = acc[ai][bj][m][0], a1 = acc[ai][bj][m][1]; const u32x4 b4 = bs[m][bj];
                    const float o0 = bf_lo(b4.x) + a0[0], o1 = bf_hi(b4.x) + a0[1], o2 = bf_lo(b4.y) + a0[2], o3 = bf_hi(b4.y) + a0[3];
                    const float o4 = bf_lo(b4.z) + a1[0], o5 = bf_hi(b4.z) + a1[1], o6 = bf_lo(b4.w) + a1[2], o7 = bf_hi(b4.w) + a1[3];
                    q += ((o0 * o0 + o1 * o1) + (o2 * o2 + o3 * o3)) + ((o4 * o4 + o5 * o5) + (o6 * o6 + o7 * o7));
                    u32x4 w; w.x = cvt_pk_bf16(o0, o1); w.y = cvt_pk_bf16(o2, o3); w.z = cvt_pk_bf16(o4, o5); w.w = cvt_pk_bf16(o6, o7);
                    *(u32x4*)(xb + off + bj * HALF) = w;
                }
                q += __shfl_xor(q, 16); q += __shfl_xor(q, 32); qs[m] = q;
            }
            { const float mine = fq == 0 ? qs[0] : (fq == 1 ? qs[1] : (fq == 2 ? qs[2] : qs[3]));
              __hip_atomic_fetch_add(ssq + (u.pm * BM + ai * HALF + wr * 64 + 16 * fq + fr), (u64)(mine * 16777216.0f), __ATOMIC_RELAXED, __HIP_MEMORY_SCOPE_AGENT); }
            asm volatile("" ::: "memory");
        }
    }
};

template <class Epi, class Sched, bool ALIGN_EPI = false, bool SP2 = false>
__device__ __forceinline__ void gemm_phase(LAS unsigned char* lds, const Gemm g, const Sched& S, const Epi& E) {
    const int tid = threadIdx.x, wid = __builtin_amdgcn_readfirstlane(tid >> 6), lane = tid & 63, wr = wid >> 2, wc = wid & 3, fr = lane & 15, fq = lane >> 4;
    const int K = g.K, nt = K / BK;
    unsigned voffA[2], voffB[2];
#pragma unroll
    for (int i = 0; i < 2; ++i) { int R, C; stage_rc(tid * 16 + i * 8192, R, C); const int Rb = Epi::PERM ? ((R & ~31) + perm32(R & 31)) : R;
        voffA[i] = (unsigned)(R * K + C) * 2u; voffB[i] = (unsigned)(Rb * K + C) * 2u; }
    const size_t kstep = (size_t)(BK * 2);
    const size_t hstep = (size_t)HALF * K * 2;
    const size_t tstep = 2 * hstep;
    const unsigned ldsw = (unsigned)wid * 1024u;
    const int aoff = lds_byte(wr * 64 + fr, fq * 8), boff = lds_byte(wc * 32 + fr, fq * 8);
#define PG8_SA(b, h) (((b) * 2 + (h)) * HTB)
#define PG8_SB(b, h) ((4 + (b) * 2 + (h)) * HTB)
#define PG8_STAGE(bufoff, gbase, voff) do { _Pragma("unroll") for (int _i = 0; _i < 2; ++_i) \
        __builtin_amdgcn_global_load_lds((const unsigned*)((const char*)(gbase) + (voff)[_i]), (LAS unsigned*)(lds + (bufoff) + ldsw + _i * 8192), 16, 0, 0); } while (0)
#define PG8_LDA(dst, b, h) do { _Pragma("unroll") for (int m = 0; m < 4; ++m) _Pragma("unroll") for (int k = 0; k < 2; ++k) dst[m][k] = *(const LAS bf16x8*)(lds + PG8_SA(b, h) + aoff + m * 2048 + k * 1024); } while (0)
#define PG8_LDB(dst, b, h) do { _Pragma("unroll") for (int n = 0; n < 2; ++n) _Pragma("unroll") for (int k = 0; k < 2; ++k) dst[n][k] = *(const LAS bf16x8*)(lds + PG8_SB(b, h) + boff + n * 2048 + k * 1024); } while (0)
#define PG8_MMA(ai, bj, At, Bt) do { __builtin_amdgcn_s_setprio(1); _Pragma("unroll") for (int m = 0; m < 4; ++m) _Pragma("unroll") for (int n = 0; n < 2; ++n) _Pragma("unroll") for (int k = 0; k < 2; ++k) \
        acc[ai][bj][m][n] = __builtin_amdgcn_mfma_f32_16x16x32_bf16(Bt[n][k], At[m][k], acc[ai][bj][m][n], 0, 0, 0); __builtin_amdgcn_s_setprio(0); } while (0)
#define PG8_WAIT_V(n) asm volatile("s_waitcnt vmcnt(" #n ")" ::: "memory")
#define PG8_WAIT_L(n) asm volatile("s_waitcnt lgkmcnt(" #n ")" ::: "memory")
#define PG8_BAR __builtin_amdgcn_s_barrier()
#define PG8_SCHED __builtin_amdgcn_sched_barrier(0)
    Unit cur, nxt; int ui = 0;
    if (!S.next(0, cur)) return;
    f32x4 acc[2][2][4][2];
#pragma unroll
    for (int a = 0; a < 2; ++a)
#pragma unroll
        for (int b = 0; b < 2; ++b)
#pragma unroll
            for (int m = 0; m < 4; ++m)
#pragma unroll
                for (int n = 0; n < 2; ++n) acc[a][b][m][n] = (f32x4){0.f, 0.f, 0.f, 0.f};
    bf16x8 At[4][2], B0[2][2], B1[2][2];
    const char* cA = (const char*)g.A + (size_t)cur.pm * tstep; const char* cB = (const char*)g.Bt + (size_t)cur.pn * tstep;
    S.a_ready(cur);
    if constexpr (SP2) {
        PG8_STAGE(PG8_SB(0, 0), cB, voffB); PG8_STAGE(PG8_SB(0, 1), cB + hstep, voffB); PG8_STAGE(PG8_SA(0, 0), cA, voffA); PG8_STAGE(PG8_SA(0, 1), cA + hstep, voffA);
        if (wr == 1) PG8_BAR;
        PG8_WAIT_V(2); PG8_BAR;
        PG8_STAGE(PG8_SB(1, 0), cB + kstep, voffB); PG8_STAGE(PG8_SA(1, 0), cA + kstep, voffA); PG8_STAGE(PG8_SB(1, 1), cB + hstep + kstep, voffB);
        PG8_WAIT_V(6); PG8_BAR;
    } else {
        PG8_STAGE(PG8_SB(0, 0), cB, voffB); PG8_STAGE(PG8_SA(0, 0), cA, voffA); PG8_STAGE(PG8_SB(0, 1), cB + hstep, voffB); PG8_STAGE(PG8_SA(0, 1), cA + hstep, voffA);
        if (wr == 1) PG8_BAR;
        PG8_WAIT_V(4); PG8_BAR;
        PG8_STAGE(PG8_SB(1, 0), cB + kstep, voffB); PG8_STAGE(PG8_SA(1, 0), cA + kstep, voffA); PG8_STAGE(PG8_SB(1, 1), cB + hstep + kstep, voffB);
        PG8_WAIT_V(6); PG8_BAR;
    }
    for (;;) {
        const bool has_next = S.next(ui + 1, nxt);
        const char* nA = has_next ? (const char*)g.A + (size_t)nxt.pm * tstep : cA; const char* nB = has_next ? (const char*)g.Bt + (size_t)nxt.pn * tstep : cB;
        for (int t = 0; t < nt; t += 2) {
            const bool last = (t == nt - 2);
            const char* a1 = cA + (size_t)(t + 1) * kstep;
            const char* a2 = last ? nA : cA + (size_t)(t + 2) * kstep; const char* b2 = last ? nB : cB + (size_t)(t + 2) * kstep;
            const char* a3 = a2 + kstep; const char* b3 = b2 + kstep;
            if (last && has_next) S.a_ready(nxt);
            if constexpr (SP2) {
            PG8_LDB(B0, 0, 0); PG8_LDB(B1, 0, 1); PG8_SCHED; PG8_LDA(At, 0, 0); PG8_STAGE(PG8_SA(1, 1), a1 + hstep, voffA);
            PG8_WAIT_V(8); PG8_WAIT_L(0); PG8_BAR; PG8_MMA(0, 0, At, B0); PG8_MMA(0, 1, At, B1); PG8_BAR; PG8_SCHED;
            PG8_LDA(At, 0, 1); PG8_STAGE(PG8_SB(0, 0), b2, voffB); PG8_STAGE(PG8_SB(0, 1), b2 + hstep, voffB); PG8_STAGE(PG8_SA(0, 0), a2, voffA);
            PG8_WAIT_V(8); PG8_WAIT_L(0); PG8_BAR; PG8_MMA(1, 0, At, B0); PG8_MMA(1, 1, At, B1); PG8_BAR; PG8_SCHED;
            PG8_LDB(B0, 1, 0); PG8_LDB(B1, 1, 1); PG8_SCHED; PG8_LDA(At, 1, 0); PG8_STAGE(PG8_SA(0, 1), a2 + hstep, voffA);
            PG8_WAIT_V(8); PG8_WAIT_L(0); PG8_BAR; PG8_MMA(0, 0, At, B0); PG8_MMA(0, 1, At, B1); PG8_BAR; PG8_SCHED;
            PG8_LDA(At, 1, 1); PG8_STAGE(PG8_SB(1, 0), b3, voffB); PG8_STAGE(PG8_SB(1, 1), b3 + hstep, voffB); PG8_STAGE(PG8_SA(1, 0), a3, voffA);
            PG8_WAIT_V(8); PG8_WAIT_L(0); PG8_BAR; PG8_MMA(1, 0, At, B0); PG8_MMA(1, 1, At, B1); PG8_BAR; PG8_SCHED;
            } else {
            PG8_LDB(B0, 0, 0); PG8_SCHED; PG8_LDA(At, 0, 0); PG8_STAGE(PG8_SA(1, 1), a1 + hstep, voffA);
            PG8_WAIT_L(8); PG8_BAR; PG8_WAIT_L(0); PG8_MMA(0, 0, At, B0); PG8_BAR; PG8_SCHED;
            PG8_LDB(B1, 0, 1); PG8_STAGE(PG8_SB(0, 0), b2, voffB);
            PG8_BAR; PG8_WAIT_L(0); PG8_MMA(0, 1, At, B1); PG8_BAR;
            PG8_LDA(At, 0, 1); PG8_STAGE(PG8_SA(0, 0), a2, voffA);
            PG8_BAR; PG8_WAIT_L(0); PG8_MMA(1, 0, At, B0); PG8_BAR; PG8_SCHED;
            PG8_STAGE(PG8_SB(0, 1), b2 + hstep, voffB);
            PG8_WAIT_V(6); PG8_BAR; PG8_MMA(1, 1, At, B1); PG8_BAR;
            PG8_LDB(B0, 1, 0); PG8_SCHED; PG8_LDA(At, 1, 0); PG8_STAGE(PG8_SA(0, 1), a2 + hstep, voffA);
            PG8_WAIT_L(8); PG8_BAR; PG8_WAIT_L(0); PG8_MMA(0, 0, At, B0); PG8_BAR; PG8_SCHED;
            PG8_LDB(B1, 1, 1); PG8_STAGE(PG8_SB(1, 0), b3, voffB);
            PG8_BAR; PG8_WAIT_L(0); PG8_MMA(0, 1, At, B1); PG8_BAR;
            PG8_LDA(At, 1, 1); PG8_STAGE(PG8_SA(1, 0), a3, voffA);
            PG8_BAR; PG8_WAIT_L(0); PG8_MMA(1, 0, At, B0); PG8_BAR; PG8_SCHED;
            PG8_STAGE(PG8_SB(1, 1), b3 + hstep, voffB);
            PG8_WAIT_V(6); PG8_BAR; PG8_MMA(1, 1, At, B1); PG8_BAR;
            }
        }
        if constexpr (ALIGN_EPI) { if (wr == 0) PG8_BAR; }
        if constexpr (!Epi::AFTER_DRAIN) { E(acc, cur, wr, wc, fr, fq); S.done(cur); }
        if (!has_next) break;
#pragma unroll
        for (int a = 0; a < 2; ++a)
#pragma unroll
            for (int b = 0; b < 2; ++b)
#pragma unroll
                for (int m = 0; m < 4; ++m)
#pragma unroll
                    for (int n = 0; n < 2; ++n) acc[a][b][m][n] = (f32x4){0.f, 0.f, 0.f, 0.f};
        cur = nxt; cA = nA; cB = nB; ++ui;
        if constexpr (ALIGN_EPI) { if (wr == 1) PG8_BAR; }
    }
    PG8_WAIT_V(0);
    if constexpr (!ALIGN_EPI) { if (wr == 0) PG8_BAR; }
    PG8_BAR;
#undef PG8_SA
#undef PG8_SB
#undef PG8_STAGE
#undef PG8_LDA
#undef PG8_LDB
#undef PG8_MMA
#undef PG8_WAIT_V
#undef PG8_WAIT_L
#undef PG8_BAR
#undef PG8_SCHED
}
}

typedef __attribute__((address_space(1))) unsigned char gchar_t;
__device__ __forceinline__ unsigned char* launder(unsigned char* p) { size_t z = 0; asm volatile("" : "+s"(z)); return p + z; }
__device__ __forceinline__ const float* gptr(const float* p) { return (const float*)(const __attribute__((address_space(1))) float*)p; }
__device__ __forceinline__ int launder_v(int x) { asm volatile("" : "+v"(x)); return x; }

#define XB_TMO      128
#define XB_XCNT(j)  (256  + 64 * (j))
#define XB_XSUB(j)  (1280 + 64 * (j))
#define XB_XGEN(j)  (2304 + 64 * (j))
#define XB_TOP      3328
#define XB_TOPGEN   3392
#define XCD_BAR_WORDS 3456
#define XB_SPIN_CAP (1u << 18)
__device__ __forceinline__ unsigned xb_ld(unsigned* p)              { return __hip_atomic_load(p, __ATOMIC_RELAXED, __HIP_MEMORY_SCOPE_AGENT); }
__device__ __forceinline__ unsigned xb_add(unsigned* p, unsigned v) { return __hip_atomic_fetch_add(p, v, __ATOMIC_RELAXED, __HIP_MEMORY_SCOPE_AGENT); }
__device__ __forceinline__ unsigned xb_xcc_id() { return (unsigned)__builtin_amdgcn_s_getreg((3 << 11) | 20) & 0xFu; }
#define XB_SPIN(cond, bar) do { unsigned _sp = 0; while (cond) { __builtin_amdgcn_s_sleep(1); \
    if ((++_sp & 255u) == 0u) { if (xb_ld(&(bar)[XB_TMO])) break; if (_sp > XB_SPIN_CAP) { atomicAdd(&(bar)[XB_TMO], 1u); break; } } } } while (0)
struct XcdBarrier { unsigned* bar; unsigned x; volatile LAS unsigned* st; };
__device__ __forceinline__ XcdBarrier xcd_barrier_post(unsigned* bar, volatile LAS unsigned* st) {
    XcdBarrier b; b.bar = bar; b.x = xb_xcc_id(); b.st = st;
    if (threadIdx.x == 0) (void)xb_add(&bar[XB_XCNT(b.x)], 1u);
    return b;
}
__device__ __forceinline__ void xcd_barrier_complete(unsigned* bar, unsigned x, unsigned& nloc, unsigned& nx) {
    const unsigned G = gridDim.x * gridDim.y * gridDim.z;
    unsigned sum, cnt, mine, sp = 0u;
    for (;;) {
        sum = 0u; cnt = 0u; mine = 0u;
#pragma unroll
        for (unsigned j = 0; j < 16; ++j) { const unsigned c = xb_ld(&bar[XB_XCNT(j)]); sum += c; cnt += (c > 0u) ? 1u : 0u; mine = (j == x) ? c : mine; }
        if (sum == G) break;
        __builtin_amdgcn_s_sleep(1);
        if ((++sp & 255u) == 0u) { if (xb_ld(&bar[XB_TMO])) break; if (sp > XB_SPIN_CAP) { atomicAdd(&bar[XB_TMO], 1u); break; } }
    }
    nloc = mine > 0u ? mine : 1u; nx = cnt > 0u ? cnt : 1u;
}
__device__ __forceinline__ void xcd_barrier(const XcdBarrier& b) {
    asm volatile("s_waitcnt vmcnt(0)" ::: "memory");
    __syncthreads();
    if (threadIdx.x == 0) {
        unsigned* bar = b.bar;
        __builtin_amdgcn_s_waitcnt(0);
        unsigned nloc = b.st[0], nx = b.st[1];
        if (nloc == 0u) { xcd_barrier_complete(bar, b.x, nloc, nx); b.st[0] = nloc; b.st[1] = nx; }
        const unsigned old = xb_add(&bar[XB_XSUB(b.x)], 1u);
        const unsigned gen = old / nloc;
        if (old + 1u == (gen + 1u) * nloc) {
            __builtin_amdgcn_fence(__ATOMIC_RELEASE, "agent");
            asm volatile("s_waitcnt vmcnt(0)" ::: "memory");
            const unsigned og = xb_add(&bar[XB_TOP], 1u);
            const unsigned tg = og / nx;
            if (og + 1u == (tg + 1u) * nx) xb_add(&bar[XB_TOPGEN], 1u);
            else XB_SPIN(xb_ld(&bar[XB_TOPGEN]) == tg, bar);
            __builtin_amdgcn_fence(__ATOMIC_ACQUIRE, "agent");
            xb_add(&bar[XB_XGEN(b.x)], 1u);
            asm volatile("s_waitcnt vmcnt(0)" ::: "memory");
        } else {
            XB_SPIN(xb_ld(&bar[XB_XGEN(b.x)]) == gen, bar);
            __builtin_amdgcn_fence(__ATOMIC_ACQUIRE, "agent");
            asm volatile("s_waitcnt vmcnt(0)" ::: "memory");
        }
    }
    __syncthreads();
}
struct Args { const float* in[19]; float* out; unsigned char* ws; int ph_lo, ph_hi; };

struct Ctx {
    const float* const* in; float* out; unsigned char* ws;
    LAS unsigned char* lds; int tid, lane, wave, G, bid;
};

__device__ __forceinline__ void tr_item(const float* W, int K, int N, bf16_t* WT, const float* gs, LAS float* scr, int item, int lane) {
    const int nblk = N / 32, kb = item / nblk, nb = item % nblk, k0 = 64 * kb, n0 = 32 * nb;
    const int c4 = (lane & 7) * 4;
#pragma unroll
    for (int i = 0; i < 8; ++i) { const int kk = 8 * i + (lane >> 3); const float s = gs ? gs[k0 + kk] : 1.f; const f32x4 v = *(const f32x4*)(W + (size_t)(k0 + kk) * N + n0 + c4) * s;
        LAS float* d = scr + kk * 33 + c4; d[0] = v[0]; d[1] = v[1]; d[2] = v[2]; d[3] = v[3]; }
    asm volatile("s_waitcnt lgkmcnt(0)" ::: "memory");
    const int c = lane & 7;
#pragma unroll
    for (int j = 0; j < 4; ++j) { const int n = (lane >> 3) + 8 * j; const LAS float* s = scr + (8 * c) * 33 + n;
        u32x4 o; o.x = pk2(s[0 * 33], s[1 * 33]); o.y = pk2(s[2 * 33], s[3 * 33]); o.z = pk2(s[4 * 33], s[5 * 33]); o.w = pk2(s[6 * 33], s[7 * 33]);
        *(u32x4*)(WT + (size_t)(n0 + n) * K + k0 + 8 * c) = o; }
    asm volatile("s_waitcnt lgkmcnt(0)" ::: "memory");
}

__device__ __forceinline__ void prologue(const Ctx& C) {
    const int gw = C.bid * 8 + C.wave, NGW = C.G * 8; const int gt = C.bid * 512 + C.tid, NGT = C.G * 512;
    { u64* s = (u64*)(C.ws + WS_SSQ) + M; for (int i = gt; i < 4 * M; i += NGT) s[i] = 0ull;
      unsigned* ctr = (unsigned*)(C.ws + WS_CTR); if (gt < 64) ctr[gt] = 0u;
      unsigned* barw = (unsigned*)(C.ws + WS_BAR); if (gt < 3456) barw[gt] = 0u;
      for (int l = 0; l < 2; ++l) { u32x4* p = (u32x4*)((bf16_t*)(C.ws + WS_W + l * W_LAYER + WO_IN) + (size_t)INC * DM); for (int i = gt; i < (INP - INC) * DM / 8; i += NGT) p[i] = (u32x4){0u, 0u, 0u, 0u}; } }
    { bf16_t* wtg = (bf16_t*)(C.ws + WS_WTG);
      for (int i = gt; i < 2 * 6 * 2 * 4096; i += NGT) { const int o = i & 63, k = (i >> 6) & 63, mat = (i >> 12) & 1, lh = i >> 13;
          const float v = (mat ? gptr(C.in[11]) : gptr(C.in[9]))[(size_t)lh * 4096 + k * 64 + o]; wtg[((size_t)(lh * 2 + mat) * 64 + o) * 64 + k] = (bf16_t)f2bf(v); } }
    LAS float* scr = (LAS float*)(C.lds + C.wave * 16384);
    constexpr int I_IN = (DM / 64) * (INC / 32), I_OUT = (DM / 64) * (DM / 32), I_UP = (DM / 64) * (FF / 32), I_DN = (FF / 64) * (DM / 32), I_L = I_IN + I_OUT + I_UP + I_DN;
    for (int it = gw; it < 2 * I_L; it += NGW) {
        const int l = it / I_L; int r = it % I_L; unsigned char* wb = C.ws + WS_W + l * W_LAYER;
        if (r < I_IN) { tr_item(gptr(C.in[2]) + (size_t)l * DM * INC, DM, INC, (bf16_t*)(wb + WO_IN), gptr(C.in[1]) + l * DM, scr, r, C.lane); continue; } r -= I_IN;
        if (r < I_OUT) { tr_item(gptr(C.in[14]) + (size_t)l * DM * DM, DM, DM, (bf16_t*)(wb + WO_OUT), nullptr, scr, r, C.lane); continue; } r -= I_OUT;
        if (r < I_UP) { tr_item(gptr(C.in[16]) + (size_t)l * DM * FF, DM, FF, (bf16_t*)(wb + WO_UP), gptr(C.in[15]) + l * DM, scr, r, C.lane); continue; } r -= I_UP;
        tr_item(gptr(C.in[17]) + (size_t)l * FF * DM, FF, DM, (bf16_t*)(wb + WO_DN), nullptr, scr, r, C.lane);
    }
    const float* x = gptr(C.in[0]); bf16_t* xb = (bf16_t*)(C.ws + WS_XB); u64* ssq0 = (u64*)(C.ws + WS_SSQ);
    for (int m0 = gw * 4; m0 < M; m0 += NGW * 4) {
        f32x4 v[4][4]; float sq[4];
#pragma unroll
        for (int r = 0; r < 4; ++r) { const f32x4* xr = (const f32x4*)(x + (size_t)(m0 + r) * DM) + 2 * C.lane;
#pragma unroll
            for (int j = 0; j < 2; ++j) { v[r][2 * j] = xr[128 * j]; v[r][2 * j + 1] = xr[128 * j + 1]; } }
#pragma unroll
        for (int r = 0; r < 4; ++r) { float s = 0.f;
#pragma unroll
            for (int j = 0; j < 4; ++j) s += (v[r][j].x * v[r][j].x + v[r][j].y * v[r][j].y) + (v[r][j].z * v[r][j].z + v[r][j].w * v[r][j].w);
            sq[r] = wave_sum(s); }
#pragma unroll
        for (int r = 0; r < 4; ++r) {
            if (C.lane == 0) ssq0[m0 + r] = (u64)(sq[r] * 16777216.0f);
            u32x4* o16 = (u32x4*)(xb + (size_t)(m0 + r) * DM) + C.lane;
#pragma unroll
            for (int j = 0; j < 2; ++j) { u32x4 w; w.x = pk2(v[r][2 * j].x, v[r][2 * j].y); w.y = pk2(v[r][2 * j].z, v[r][2 * j].w); w.z = pk2(v[r][2 * j + 1].x, v[r][2 * j + 1].y); w.w = pk2(v[r][2 * j + 1].z, v[r][2 * j + 1].w); o16[64 * j] = w; } }
    }
}

struct MixCtx { const bf16_t* Z; bf16_t* MIX; bf16_t* AO; float* LSE; bf16_t* Y2; float* SUM; const bf16_t* WTG; const float* const* in; int l; };
__device__ __forceinline__ MixCtx mk_mix(unsigned char* ws, const float* const* in, int l) { ws = launder(ws); asm volatile("" : "+s"(l));
    MixCtx X; X.Z = (const bf16_t*)(ws + WS_Z); X.MIX = (bf16_t*)(ws + WS_MIX); X.AO = (bf16_t*)(ws + WS_AO); X.LSE = (float*)(ws + WS_LSE); X.Y2 = (bf16_t*)(ws + WS_Y2); X.SUM = (float*)(ws + WS_SUM); X.WTG = (const bf16_t*)(ws + WS_WTG); X.in = in; X.l = l; return X; }

struct AttnPre { u32x4 k[4], v[4]; bf16x8 q0, q1; };
__device__ __forceinline__ void attn_load(const bf16_t* Z, int a, int tid, AttnPre& P) {
    const int lane = tid & 63, w = tid >> 6;
    const int b = a / 96, rem = a % 96, h = rem >> 4, u16 = rem & 15;
    const int sh = 2 * (h >> 1), dil = 1 << sh, nbm = (16 >> sh) - 1;
    const int r = u16 >> (4 - sh), n = u16 & nbm;
    const bf16_t* zb = Z + (size_t)b * SEQ * INC;
#pragma unroll
    for (int i = 0; i < 4; ++i) { const int c = tid + 512 * i; const int row = c >> 3, ch = c & 7; const int sub = (n - 1) * 128 + row;
        P.k[i] = (u32x4){0u, 0u, 0u, 0u}; P.v[i] = (u32x4){0u, 0u, 0u, 0u};
        if (sub >= 0) { const size_t off = (size_t)(sub * dil + r) * INC + h * 64 + ch * 8; P.k[i] = *(const u32x4*)(zb + off + K0); P.v[i] = *(const u32x4*)(zb + off + V0); } }
    const int j = lane & 15, kq = lane >> 4; const int qi = 16 * w + j; const int qpos = (n * 128 + qi) * dil + r;
    const bf16_t* qp = zb + (size_t)qpos * INC + Q0 + h * 64 + kq * 8;
    P.q0 = *(const bf16x8*)qp; P.q1 = *(const bf16x8*)(qp + 32);
}
__device__ __forceinline__ void attn_compute(const MixCtx& X, int a, LAS unsigned char* lds, int tid, const bf16x8 q0, const bf16x8 q1) {
    const int lane = tid & 63, w = __builtin_amdgcn_readfirstlane(tid >> 6);
    const int b = a / 96, rem = a % 96, h = rem >> 4, u16 = rem & 15;
    const int sh = 2 * (h >> 1), dil = 1 << sh, nbm = (16 >> sh) - 1;
    const int r = u16 >> (4 - sh), n = u16 & nbm;
    const float slope = exp2f(-8.0f * (float)(h + 1) / 6.0f);
    const float c1 = 0.125f * LOG2E, c2 = slope * (float)dil * LOG2E;
    LAS unsigned char* Kl = lds; LAS unsigned char* Vl = lds + 39168;
    const int j = lane & 15, kq = lane >> 4;
    const int qi = 16 * w + j; const int qpos = (n * 128 + qi) * dil + r;
    float s[9][4]; float mx = -1e30f;
    const int d0 = j + 128 - 4 * kq;
    float be[4]; const float bstep = 16.0f * c2;
#pragma unroll
    for (int e = 0; e < 4; ++e) be[e] = -c2 * (float)(d0 - e);
    const int nlive0 = (n == 0) ? (8 - w) : 0;
#pragma unroll
    for (int tt = 0; tt < 9; ++tt) {
        if (tt >= nlive0) {
            const int kt = w + tt; const LAS unsigned char* p = Kl + (16 * kt + j) * 144 + kq * 16;
            const bf16x8 k0f = *(const LAS bf16x8*)p, k1f = *(const LAS bf16x8*)(p + 64);
            f32x4 acc = (f32x4){0.f, 0.f, 0.f, 0.f};
            acc = __builtin_amdgcn_mfma_f32_16x16x32_bf16(k0f, q0, acc, 0, 0, 0);
            acc = __builtin_amdgcn_mfma_f32_16x16x32_bf16(k1f, q1, acc, 0, 0, 0);
#pragma unroll
            for (int e = 0; e < 4; ++e) {
                float v = acc[e] * c1 + (be[e] + bstep * (float)tt);
                if (tt == 0) { if (d0 - e > 128) v = -1e30f; }
                if (tt == 8) { if (d0 - 128 - e < 0) v = -1e30f; }
                s[tt][e] = v; mx = fmaxf(mx, v); }
        } else {
#pragma unroll
            for (int e = 0; e < 4; ++e) s[tt][e] = -1e30f;
        }
    }
    mx = fmaxf(mx, __shfl_xor(mx, 16)); mx = fmaxf(mx, __shfl_xor(mx, 32));
    float l = 0.f;
#pragma unroll
    for (int tt = 0; tt < 9; ++tt) {
        if (tt >= nlive0) {
#pragma unroll
            for (int e = 0; e < 4; ++e) { const float pv = __builtin_amdgcn_exp2f(s[tt][e] - mx); s[tt][e] = pv; l += pv; }
        } else {
#pragma unroll
            for (int e = 0; e < 4; ++e) s[tt][e] = 0.f;
        }
    }
    l += __shfl_xor(l, 16); l += __shfl_xor(l, 32);
    f32x4 o[4];
#pragma unroll
    for (int dt = 0; dt < 4; ++dt) o[dt] = (f32x4){0.f, 0.f, 0.f, 0.f};
    const int qq = (lane & 15) >> 2, pp = lane & 3;
#pragma unroll
    for (int c = 0; c < 5; ++c) {
        if (2 * c + 1 >= nlive0) {
            u32x4 pw; pw.x = cvt_pk_bf16(s[2 * c][0], s[2 * c][1]); pw.y = cvt_pk_bf16(s[2 * c][2], s[2 * c][3]);
            if (c < 4) { pw.z = cvt_pk_bf16(s[2 * c + 1][0], s[2 * c + 1][1]); pw.w = cvt_pk_bf16(s[2 * c + 1][2], s[2 * c + 1][3]); } else { pw.z = 0u; pw.w = 0u; }
            const bf16x8 pb = __builtin_bit_cast(bf16x8, pw);
            const int row = 16 * (w + 2 * c) + 4 * kq + qq;
#pragma unroll
            for (int dt = 0; dt < 4; ++dt) {
                LAS unsigned char* vp = Vl + row * 160 + (16 * dt + 4 * pp) * 2;
                const v4i16_t lo = __builtin_amdgcn_ds_read_tr16_b64_v4i16((LAS v4i16_t*)vp);
                const v4i16_t hi = __builtin_amdgcn_ds_read_tr16_b64_v4i16((LAS v4i16_t*)(vp + 16 * 160));
                const bf16x8 vf = (bf16x8){lo[0], lo[1], lo[2], lo[3], hi[0], hi[1], hi[2], hi[3]};
                o[dt] = __builtin_amdgcn_mfma_f32_16x16x32_bf16(vf, pb, o[dt], 0, 0, 0);
            }
        }
    }
    const float inv = 1.0f / l;
    bf16_t* op = X.AO + ((size_t)b * SEQ + qpos) * AW + h * 64 + 4 * kq;
#pragma unroll
    for (int dt = 0; dt < 4; ++dt) { u32x2 wv; wv.x = cvt_pk_bf16(o[dt][0] * inv, o[dt][1] * inv); wv.y = cvt_pk_bf16(o[dt][2] * inv, o[dt][3] * inv); *(u32x2*)(op + 16 * dt) = wv; }
    if (kq == 0) X.LSE[((size_t)b * SEQ + qpos) * 6 + h] = (mx + __log2f(l)) * LN2;
}
__device__ __forceinline__ void attn_loop(unsigned char* ws_, const float* const* in_, int l_, LAS unsigned char* lds, int tid, int a_start, int a_cnt, int a_stride) {
    const MixCtx X = mk_mix(ws_, in_, l_); tid = launder_v(tid);
    LAS unsigned char* Kl = lds; LAS unsigned char* Vl = lds + 39168;
    if (tid < 128) { const int row = 256 + (tid >> 3), ch = tid & 7; const unsigned z = (unsigned)launder_v(0); const u32x4 zz = (u32x4){z, z, z, z}; *(LAS u32x4*)(Kl + row * 144 + ch * 16) = zz; *(LAS u32x4*)(Vl + row * 160 + ch * 16) = zz; }
    AttnPre P; int a = a_start;
    if (a_cnt > 0) attn_load(X.Z, a, tid, P);
    for (int k = 0; k < a_cnt; ++k, a += a_stride) {
        __syncthreads();
#pragma unroll
        for (int i = 0; i < 4; ++i) { const int c = tid + 512 * i; const int row = c >> 3, ch = c & 7;
            *(LAS u32x4*)(Kl + row * 144 + ch * 16) = P.k[i]; *(LAS u32x4*)(Vl + row * 160 + ch * 16) = P.v[i]; }
        const bf16x8 q0 = P.q0, q1 = P.q1;
        __syncthreads();
        if (k + 1 < a_cnt) attn_load(X.Z, a + a_stride, tid, P);
        attn_compute(X, a, lds, tid, q0, q1);
    }
    __syncthreads();
}

__device__ __forceinline__ void conv_glu8(const u32x4 av, const u32x4 gv, f32x4& u0, f32x4& u1) {
    u0[0] = bf_lo(av.x) * sigmoidf_(bf_lo(gv.x)); u0[1] = bf_hi(av.x) * sigmoidf_(bf_hi(gv.x)); u0[2] = bf_lo(av.y) * sigmoidf_(bf_lo(gv.y)); u0[3] = bf_hi(av.y) * sigmoidf_(bf_hi(gv.y));
    u1[0] = bf_lo(av.z) * sigmoidf_(bf_lo(gv.z)); u1[1] = bf_hi(av.z) * sigmoidf_(bf_hi(gv.z)); u1[2] = bf_lo(av.w) * sigmoidf_(bf_lo(gv.w)); u1[3] = bf_hi(av.w) * sigmoidf_(bf_hi(gv.w));
}
__device__ __forceinline__ int ring94(int r) { return r >= 94 ? r - 94 : r; }
template <int S> struct ConvStep {
    static __device__ __forceinline__ void run(float (&acc)[32], const float (&wv)[31], const LAS float* U, int rb, int cch) {
        const float uv = U[ring94(ring94(rb + S)) * 256 + cch];
#pragma unroll
        for (int o = 0; o < 32; ++o) { constexpr int dummy = 0; const int kk = S - o + dummy; if (kk >= 0 && kk <= 30) acc[o] += wv[kk] * uv; }
        ConvStep<S + 1>::run(acc, wv, U, rb, cch);
    }
};
template <> struct ConvStep<62> { static __device__ __forceinline__ void run(float (&)[32], const float (&)[31], const LAS float*, int, int) {} };
__device__ __forceinline__ void conv_loop(unsigned char* ws_, const float* const* in_, int l_, LAS unsigned char* lds, int tid, int bid, int G) {
    const MixCtx X = mk_mix(ws_, in_, l_); tid = launder_v(tid);
    const int lane = tid & 63, w = tid >> 6;
    LAS float* U = (LAS float*)lds;
    const int cch = tid & 255, half = tid >> 8;
    const float* cw = gptr(X.in[3]) + (size_t)X.l * 31 * CW; float wv[31]; int cwo = cch;
#pragma unroll
    for (int k = 0; k < 31; ++k) { wv[k] = cw[cwo]; cwo += CW; asm volatile("" : "+v"(cwo)); }
    const float bias = gptr(X.in[4])[X.l * CW + cch];
    const f32x4 gg = *(const f32x4*)(gptr(X.in[5]) + X.l * CW + 4 * lane), bb = *(const f32x4*)(gptr(X.in[6]) + X.l * CW + 4 * lane);
    for (int cc = bid; cc < BATCH * 8; cc += G) {
        const int b = cc >> 3, tb = (cc & 7) * 4;
        const bf16_t* zb = X.Z + (size_t)b * SEQ * INC;
        u32x4 pa[4], pg[4];
#pragma unroll
        for (int i = 0; i < 4; ++i) { const int idx = tid + 512 * i; const int row = idx >> 5, ch = idx & 31; const size_t t = (size_t)(tb * 64 + row);
            pa[i] = *(const u32x4*)(zb + t * INC + CA0 + ch * 8); pg[i] = *(const u32x4*)(zb + t * INC + CG0 + ch * 8); }
        __syncthreads();
#pragma unroll
        for (int i = 0; i < 2; ++i) { const int idx = tid + 512 * i; if (idx < 30 * 32) { const int row = idx >> 5, ch = idx & 31; const int t = tb * 64 - 30 + row;
            f32x4 u0 = (f32x4){0.f, 0.f, 0.f, 0.f}, u1 = u0;
            if (t >= 0) { const u32x4 av = *(const u32x4*)(zb + (size_t)t * INC + CA0 + ch * 8), gv = *(const u32x4*)(zb + (size_t)t * INC + CG0 + ch * 8); conv_glu8(av, gv, u0, u1); }
            *(LAS f32x4*)(U + row * 256 + ch * 8) = u0; *(LAS f32x4*)(U + row * 256 + ch * 8 + 4) = u1; } }
        int base = 0;
        for (int k = 0; k < 4; ++k) {
            const int t0 = (tb + k) * 64;
#pragma unroll
            for (int i = 0; i < 4; ++i) { const int idx = tid + 512 * i; const int row = ring94(base + 30 + (idx >> 5)), ch = idx & 31; f32x4 u0, u1; conv_glu8(pa[i], pg[i], u0, u1);
                *(LAS f32x4*)(U + row * 256 + ch * 8) = u0; *(LAS f32x4*)(U + row * 256 + ch * 8 + 4) = u1; }
            __syncthreads();
            if (k < 3) {
#pragma unroll
                for (int i = 0; i < 4; ++i) { const int idx = tid + 512 * i; const int row = idx >> 5, ch = idx & 31; const size_t t = (size_t)(t0 + 64 + row);
                    pa[i] = *(const u32x4*)(zb + t * INC + CA0 + ch * 8); pg[i] = *(const u32x4*)(zb + t * INC + CG0 + ch * 8); }
            }
            float acc[32];
#pragma unroll
            for (int o = 0; o < 32; ++o) acc[o] = bias;
            const int rb = base + 32 * half;
            ConvStep<0>::run(acc, wv, U, rb, cch);
            __syncthreads();
#pragma unroll
            for (int o = 0; o < 32; ++o) U[ring94(ring94(rb + o)) * 256 + cch] = acc[o];
            __syncthreads();
#pragma unroll
            for (int i = 0; i < 8; ++i) { const int tok = 8 * w + i; f32x4 v = *(LAS f32x4*)(U + ring94(base + tok) * 256 + 4 * lane);
                const float mean = wave_sum((v[0] + v[1]) + (v[2] + v[3])) * (1.0f / 256.0f);
                v = v - mean; const float var = wave_sum((v[0] * v[0] + v[1] * v[1]) + (v[2] * v[2] + v[3] * v[3])) * (1.0f / 256.0f);
                const float rstd = rsqrtf(var + LN_EPS); f32x4 y = v * rstd * gg + bb;
#pragma unroll
                for (int e = 0; e < 4; ++e) y[e] = y[e] * sigmoidf_(y[e]);
                u32x2 wv2; wv2.x = cvt_pk_bf16(y[0], y[1]); wv2.y = cvt_pk_bf16(y[2], y[3]);
                *(u32x2*)(X.MIX + ((size_t)b * SEQ + t0 + tok) * DM + AW + 4 * lane) = wv2; }
            __syncthreads();
            base = ring94(base + 64);
        }
    }
}

constexpr int LR_UB = 0, LR_A = 18432, LR_B = 53248, LR_WT = 88064, LR_PRM = 106496, LR_SA = 107264, LR_SB = 109312, LR_GT = 111360, LR_CAR = 129792;
__device__ __forceinline__ float gelu_tanh(float x) { const float y = 0.7978845608028654f * (x + 0.044715f * x * x * x); const float e = __expf(2.f * y); return 0.5f * x * (2.f - 2.f * __builtin_amdgcn_rcpf(1.f + e)); }
struct LruPre { u32x4 x[5], g[2]; };
__device__ __forceinline__ void lru_load(const MixCtx& X, int b, int h, int chunk, int tid, LruPre& P) {
    const int c0 = h * 64, t0 = chunk * 128;
    const bf16_t* zb = X.Z + (size_t)b * SEQ * INC; const int cg8 = tid & 7, tp = tid >> 3;
#pragma unroll
    for (int rr = 0; rr < 5; ++rr) { const int t = t0 + 2 * tp - 3 + rr; P.x[rr] = (u32x4){0u, 0u, 0u, 0u}; if (t >= 0) P.x[rr] = *(const u32x4*)(zb + (size_t)t * INC + LX0 + c0 + 8 * cg8); }
#pragma unroll
    for (int i = 0; i < 2; ++i) { const int idx = tid + 512 * i; const int row = idx >> 3, ch = idx & 7;
        P.g[i] = *(const u32x4*)(zb + (size_t)(t0 + row) * INC + LG0 + c0 + ch * 8); }
}
__device__ __forceinline__ void lru_chain(unsigned char* ws_, const float* const* in_, int l_, LAS unsigned char* lds, int tid, int bid, int G) {
    const MixCtx X = mk_mix(ws_, in_, l_); tid = launder_v(tid);
    const int lane = tid & 63, w = __builtin_amdgcn_readfirstlane(tid >> 6); const int l = X.l;
    LAS unsigned char* UB = lds + LR_UB; LAS float* A_ = (LAS float*)(lds + LR_A); LAS float* B_ = (LAS float*)(lds + LR_B);
    LAS unsigned char* WT = lds + LR_WT; LAS float* PRM = (LAS float*)(lds + LR_PRM); LAS float* SA = (LAS float*)(lds + LR_SA); LAS float* SB = (LAS float*)(lds + LR_SB); LAS unsigned char* GT = lds + LR_GT;
    LAS float* CAR = (LAS float*)(lds + LR_CAR);
    const int cg8 = tid & 7, tp = tid >> 3; const int j = lane & 15, kq = lane >> 4;
    for (int chain = bid; chain < BATCH * 6; chain += G) {
        const int b = chain / 6, h = chain % 6, c0 = h * 64;
        LruPre P; lru_load(X, b, h, 0, tid, P);
        f32x4 cwv[4][2], cbv[2];
#pragma unroll
        for (int e2 = 0; e2 < 2; ++e2) { cbv[e2] = *(const f32x4*)(gptr(X.in[8]) + l * LW + c0 + 8 * cg8 + 4 * e2);
#pragma unroll
            for (int k = 0; k < 4; ++k) cwv[k][e2] = *(const f32x4*)(gptr(X.in[7]) + (size_t)(l * 4 + k) * LW + c0 + 8 * cg8 + 4 * e2); }
        __syncthreads();
#pragma unroll
        for (int i = 0; i < 2; ++i) { const int idx = tid + 512 * i; const int row = idx >> 3, ch = idx & 7;
            *(LAS u32x4*)(WT + row * 144 + ch * 16) = *(const u32x4*)(X.WTG + (size_t)(l * 6 + h) * 8192 + idx * 8); }
        if (tid < 64) { PRM[tid] = gptr(X.in[10])[l * LW + c0 + tid]; PRM[64 + tid] = gptr(X.in[12])[l * LW + c0 + tid]; PRM[128 + tid] = log1pf(__expf(-gptr(X.in[13])[l * LW + c0 + tid])); CAR[tid] = 0.f; }
        LAS unsigned char* OT = lds + LR_A;
        for (int chunk = 0; chunk < 16; ++chunk) {
            const int t0 = chunk * 128;
            if (chunk > 0) {
#pragma unroll
                for (int i = 0; i < 2; ++i) { const int idx = tid + 512 * i; const int row = idx >> 3, ch = idx & 7;
                    *(u32x4*)(X.MIX + ((size_t)b * SEQ + t0 - 128 + row) * DM + AW + CW + c0 + ch * 8) = *(const LAS u32x4*)(OT + row * 144 + ch * 16); }
            }
#pragma unroll
            for (int i = 0; i < 2; ++i) { const int idx = tid + 512 * i; const int row = idx >> 3, ch = idx & 7; *(LAS u32x4*)(GT + row * 144 + ch * 16) = P.g[i]; }
            { f32x4 xv[5][2];
#pragma unroll
              for (int rr = 0; rr < 5; ++rr) { const u32x4 v = P.x[rr]; xv[rr][0] = (f32x4){bf_lo(v.x), bf_hi(v.x), bf_lo(v.y), bf_hi(v.y)}; xv[rr][1] = (f32x4){bf_lo(v.z), bf_hi(v.z), bf_lo(v.w), bf_hi(v.w)}; }
#pragma unroll
              for (int tk = 0; tk < 2; ++tk) { f32x4 u0 = cbv[0], u1 = cbv[1];
#pragma unroll
                  for (int k = 0; k < 4; ++k) { u0 += cwv[k][0] * xv[tk + k][0]; u1 += cwv[k][1] * xv[tk + k][1]; }
                  const int tok = 2 * tp + tk;
                  u32x4 pw; pw.x = cvt_pk_bf16(u0[0], u0[1]); pw.y = cvt_pk_bf16(u0[2], u0[3]); pw.z = cvt_pk_bf16(u1[0], u1[1]); pw.w = cvt_pk_bf16(u1[2], u1[3]);
                  *(LAS u32x4*)(UB + tok * 144 + cg8 * 16) = pw;
                  *(LAS f32x4*)(B_ + tok * 68 + cg8 * 8) = u0; *(LAS f32x4*)(B_ + tok * 68 + cg8 * 8 + 4) = u1; } }
            __syncthreads();
            if (chunk < 15) lru_load(X, b, h, chunk + 1, tid, P);
            { const int tok = 16 * w + j; bf16x8 bfr[2];
#pragma unroll
              for (int c = 0; c < 2; ++c) bfr[c] = *(const LAS bf16x8*)(UB + tok * 144 + kq * 16 + c * 64);
#pragma unroll
              for (int ot = 0; ot < 4; ++ot) { f32x4 da = (f32x4){0.f, 0.f, 0.f, 0.f}, dx = da;
#pragma unroll
                  for (int c = 0; c < 2; ++c) { const bf16x8 fa = *(const LAS bf16x8*)(WT + (16 * ot + j) * 144 + kq * 16 + c * 64), fx = *(const LAS bf16x8*)(WT + (64 + 16 * ot + j) * 144 + kq * 16 + c * 64);
                      da = __builtin_amdgcn_mfma_f32_16x16x32_bf16(fa, bfr[c], da, 0, 0, 0); dx = __builtin_amdgcn_mfma_f32_16x16x32_bf16(fx, bfr[c], dx, 0, 0, 0); }
                  const int ch = 16 * ot + 4 * kq;
                  const f32x4 ba4 = *(const LAS f32x4*)(PRM + ch), bx4 = *(const LAS f32x4*)(PRM + 64 + ch), sp4 = *(const LAS f32x4*)(PRM + 128 + ch);
                  const f32x4 u4 = *(const LAS f32x4*)(B_ + tok * 68 + ch); f32x4 a4, b4;
#pragma unroll
                  for (int e = 0; e < 4; ++e) { const float rg = sigmoidf_(da[e] + ba4[e]), ig = sigmoidf_(dx[e] + bx4[e]); const float la = -8.0f * rg * sp4[e];
                      const float av_ = __expf(la); a4[e] = av_; b4[e] = sqrtf(fmaxf(1.0f - av_ * av_, 0.f)) * ig * u4[e]; }
                  *(LAS f32x4*)(A_ + tok * 68 + ch) = a4; *(LAS f32x4*)(B_ + tok * 68 + ch) = b4; } }
            __syncthreads();
            float av[16], bv[16]; float hh = 0.f, aa = 1.f;
#pragma unroll
            for (int i = 0; i < 16; ++i) { av[i] = A_[(16 * w + i) * 68 + lane]; bv[i] = B_[(16 * w + i) * 68 + lane]; hh = av[i] * hh + bv[i]; aa *= av[i]; }
            SA[w * 64 + lane] = aa; SB[w * 64 + lane] = hh;
            __syncthreads();
            float hin = CAR[(chunk & 1) * 64 + lane];
            for (int sgi = 0; sgi < w; ++sgi) hin = SA[sgi * 64 + lane] * hin + SB[sgi * 64 + lane];
            hh = hin;
#pragma unroll
            for (int i = 0; i < 16; i += 2) { hh = av[i] * hh + bv[i]; const float h0 = hh; hh = av[i + 1] * hh + bv[i + 1]; const int tl = 16 * w + i;
                const float g0 = gelu_tanh(bf2f(*(const LAS bf16_t*)(GT + tl * 144 + lane * 2))), g1 = gelu_tanh(bf2f(*(const LAS bf16_t*)(GT + (tl + 1) * 144 + lane * 2)));
                const unsigned pk = cvt_pk_bf16(g0 * h0, g1 * hh);
                *(LAS bf16_t*)(OT + tl * 144 + lane * 2) = (bf16_t)(pk & 0xffffu); *(LAS bf16_t*)(OT + (tl + 1) * 144 + lane * 2) = (bf16_t)(pk >> 16); }
            if (w == 7) CAR[((chunk + 1) & 1) * 64 + lane] = hh;
            __syncthreads();
        }
#pragma unroll
        for (int i = 0; i < 2; ++i) { const int idx = tid + 512 * i; const int row = idx >> 3, ch = idx & 7;
            *(u32x4*)(X.MIX + ((size_t)b * SEQ + 15 * 128 + row) * DM + AW + CW + c0 + ch * 8) = *(const LAS u32x4*)(OT + row * 144 + ch * 16); }
    }
}

__device__ __forceinline__ void mixer_phase(const Ctx& C, int l) {
    lru_chain(C.ws, C.in, l, C.lds, C.tid, C.bid, C.G);
    int a_start, a_cnt, a_stride;
    if (C.G == 256) { if (C.bid >= 192) { a_start = (C.bid - 192) * 27; a_cnt = 27; } else { a_start = 64 * 27 + C.bid * 7; a_cnt = 7; } a_stride = 1; }
    else { a_start = C.bid; a_stride = C.G; a_cnt = (N_ATT - C.bid + C.G - 1) / C.G; }
    attn_loop(C.ws, C.in, l, C.lds, C.tid, a_start, a_cnt, a_stride);
    conv_loop(C.ws, C.in, l, C.lds, C.tid, C.bid, C.G);
}

__device__ __forceinline__ void alpha_phase(const Ctx& C) {
    const bf16_t* AO = (const bf16_t*)(C.ws + WS_AO); bf16_t* MIX = (bf16_t*)(C.ws + WS_MIX); const float* LSE = (const float*)(C.ws + WS_LSE);
    const int gw = C.bid * 8 + C.wave, NGW = C.G * 8;
    for (int tg = gw; tg < M / 4; tg += NGW) {
#pragma unroll
        for (int i = 0; i < 3; ++i) { const int L = C.lane + 64 * i; const size_t tok = (size_t)4 * tg + L / 48; const int ch = L % 48, h = ch >> 3, jj = h & 1, g = h >> 1;
            const float l0 = LSE[tok * 6 + jj], l1 = LSE[tok * 6 + 2 + jj], l2 = LSE[tok * 6 + 4 + jj];
            const float mx = fmaxf(l0, fmaxf(l1, l2)); const float e0 = __expf(l0 - mx), e1 = __expf(l1 - mx), e2 = __expf(l2 - mx);
            const float al = (g == 0 ? e0 : (g == 1 ? e1 : e2)) / (e0 + e1 + e2);
            const u32x4 v = *(const u32x4*)(AO + tok * AW + ch * 8); u32x4 o;
            o.x = pk2(bf_lo(v.x) * al, bf_hi(v.x) * al); o.y = pk2(bf_lo(v.y) * al, bf_hi(v.y) * al); o.z = pk2(bf_lo(v.z) * al, bf_hi(v.z) * al); o.w = pk2(bf_lo(v.w) * al, bf_hi(v.w) * al);
            *(u32x4*)(MIX + tok * DM + ch * 8) = o; }
    }
}

__device__ __forceinline__ void final_phase(const Ctx& C) {
    const u64* ssq = (const u64*)(C.ws + WS_SSQ) + 4 * (size_t)M; const float* g = gptr(C.in[18]);
    const int gw = C.bid * 8 + C.wave, NGW = C.G * 8;
    f32x4 gv[4];
#pragma unroll
    for (int j = 0; j < 2; ++j) { gv[2 * j] = *((const f32x4*)g + 2 * C.lane + 128 * j); gv[2 * j + 1] = *((const f32x4*)g + 2 * C.lane + 128 * j + 1); }
    const bf16_t* XB = (const bf16_t*)(C.ws + WS_XB);
    for (int m0 = gw * 4; m0 < M; m0 += NGW * 4) {
        u32x4 v[4][2]; float ri[4];
#pragma unroll
        for (int r = 0; r < 4; ++r) { ri[r] = rinv_from(__hip_atomic_load(ssq + m0 + r, __ATOMIC_RELAXED, __HIP_MEMORY_SCOPE_AGENT)); const u32x4* xi = (const u32x4*)(XB + (size_t)(m0 + r) * DM) + C.lane;
#pragma unroll
            for (int j = 0; j < 2; ++j) v[r][j] = xi[64 * j]; }
#pragma unroll
        for (int r = 0; r < 4; ++r) { f32x4* xr = (f32x4*)(C.out + (size_t)(m0 + r) * DM) + 2 * C.lane;
#pragma unroll
            for (int j = 0; j < 2; ++j) { const u32x4 q = v[r][j];
                xr[128 * j] = (f32x4){bf_lo(q.x), bf_hi(q.x), bf_lo(q.y), bf_hi(q.y)} * ri[r] * gv[2 * j];
                xr[128 * j + 1] = (f32x4){bf_lo(q.z), bf_hi(q.z), bf_lo(q.w), bf_hi(q.w)} * ri[r] * gv[2 * j + 1]; } }
    }
}

constexpr int N_PHASES = 14;
__global__ void __launch_bounds__(512, 2) fwd_kernel(Args args) {
    extern __shared__ __attribute__((aligned(16))) unsigned char lds_raw[];
#define IN(k) (true)
#define MKCTX Ctx C; C.in = args.in; C.out = (float*)launder((unsigned char*)args.out); C.ws = launder(args.ws); C.lds = (LAS unsigned char*)lds_raw; \
    C.tid = launder_v((int)threadIdx.x); C.lane = C.tid & 63; C.wave = __builtin_amdgcn_readfirstlane(C.tid >> 6); C.G = gridDim.x; C.bid = blockIdx.x;
    LAS unsigned char* const ldsp = (LAS unsigned char*)lds_raw; const int G_ = gridDim.x, bid_ = blockIdx.x;
#define SYNC(k) do { xcd_barrier(xbar); } while (0)
    { volatile LAS unsigned* misc = (volatile LAS unsigned*)(lds_raw + MISC_OFF); if (threadIdx.x < 16) misc[threadIdx.x] = 0u; __syncthreads(); }
    if (IN(0)) { MKCTX; prologue(C); }
    cg::this_grid().sync();
    XcdBarrier xbar = xcd_barrier_post((unsigned*)(args.ws + WS_BAR), (volatile LAS unsigned*)((LAS unsigned char*)lds_raw + MISC_OFF + 32));
    for (int l = 0; l < 2; ++l) {
        asm volatile("" : "+s"(l));
        const int pb = 1 + 6 * l;
        if (IN(pb)) {
            unsigned char* ws = launder(args.ws); unsigned char* wb = ws + WS_W + l * W_LAYER;
            pg8::Gemm g{(const bf16_t*)(ws + WS_XB), (const bf16_t*)(wb + WO_IN), M, INP, DM}; pg8::StaticOrder S; S.init(M, INP, G_, bid_);
            pg8::EpiRowScale<0> E{(bf16_t*)(ws + WS_Z), INC, (const u64*)(ws + WS_SSQ) + (size_t)(2 * l) * M, INC};
            pg8::gemm_phase<pg8::EpiRowScale<0>, pg8::StaticOrder, true, true>(ldsp, g, S, E);
        }
        SYNC(pb);
        if (IN(pb + 1)) { MKCTX; mixer_phase(C, l); }
        SYNC(pb + 1);
        if (IN(pb + 2)) { MKCTX; alpha_phase(C); }
        SYNC(pb + 2);
        if (IN(pb + 3)) {
            unsigned char* ws = launder(args.ws); unsigned char* wb = ws + WS_W + l * W_LAYER;
            pg8::Gemm g{(const bf16_t*)(ws + WS_MIX), (const bf16_t*)(wb + WO_OUT), M, DM, DM}; pg8::StaticOrder S; S.init(M, DM, G_, bid_);
            pg8::EpiResid E{(bf16_t*)(ws + WS_XB), (u64*)(ws + WS_SSQ) + (size_t)(2 * l + 1) * M};
            pg8::gemm_phase<pg8::EpiResid, pg8::StaticOrder, true, true>(ldsp, g, S, E);
        }
        SYNC(pb + 3);
        if (IN(pb + 4)) {
            unsigned char* ws = launder(args.ws); unsigned char* wb = ws + WS_W + l * W_LAYER;
            pg8::Gemm g{(const bf16_t*)(ws + WS_XB), (const bf16_t*)(wb + WO_UP), M, FF, DM}; pg8::StaticOrder S; S.init(M, FF, G_, bid_);
            pg8::EpiRowScale<1> E{(bf16_t*)(ws + WS_BIG), FF, (const u64*)(ws + WS_SSQ) + (size_t)(2 * l + 1) * M, FF};
            pg8::gemm_phase<pg8::EpiRowScale<1>, pg8::StaticOrder, true, true>(ldsp, g, S, E);
        }
        SYNC(pb + 4);
        if (IN(pb + 5)) {
            unsigned char* ws = launder(args.ws); unsigned char* wb = ws + WS_W + l * W_LAYER;
            pg8::Gemm g{(const bf16_t*)(ws + WS_BIG), (const bf16_t*)(wb + WO_DN), M, DM, FF}; pg8::StaticOrder S; S.init(M, DM, G_, bid_);
            pg8::EpiResid E{(bf16_t*)(ws + WS_XB), (u64*)(ws + WS_SSQ) + (size_t)(2 * l + 2) * M};
            pg8::gemm_phase<pg8::EpiResid, pg8::StaticOrder, true, true>(ldsp, g, S, E);
        }
        SYNC(pb + 5);
    }
    if (IN(13)) { MKCTX; final_phase(C); }
#undef IN
#undef SYNC
#undef MKCTX
}

extern "C" void kernel_launch(void* const* d_in, const int* in_sizes, int n_in, void* d_out, int out_size, void* d_ws, size_t ws_size, hipStream_t stream) {
    static int grid = 0;
    if (grid == 0) {
        if (n_in != 19 || in_sizes[0] != M * DM || out_size != M * DM || ws_size < WS_END) { fprintf(stderr, "kernel_launch: unexpected shapes (n_in %d, in0 %d, out %d, ws %zu)\n", n_in, n_in > 0 ? in_sizes[0] : -1, out_size, ws_size); grid = -1; return; }
        int dev = 0, cus = 0, per_cu = 0;
        if (hipGetDevice(&dev) != hipSuccess || hipDeviceGetAttribute(&cus, hipDeviceAttributeMultiprocessorCount, dev) != hipSuccess) { grid = -1; return; }
        if (hipFuncSetAttribute((const void*)fwd_kernel, hipFuncAttributeMaxDynamicSharedMemorySize, LDS_BYTES) != hipSuccess) { fprintf(stderr, "kernel_launch: hipFuncSetAttribute failed\n"); grid = -1; return; }
        if (hipOccupancyMaxActiveBlocksPerMultiprocessor(&per_cu, (const void*)fwd_kernel, 512, LDS_BYTES) != hipSuccess || per_cu < 1) { fprintf(stderr, "kernel_launch: occupancy query says %d\n", per_cu); per_cu = 1; }
        (void)hipGetLastError();
        grid = cus * per_cu;
    }
    if (grid < 0) return;
    Args a{};
    for (int i = 0; i < 19; ++i) a.in[i] = (const float*)d_in[i];
    a.out = (float*)d_out; a.ws = (unsigned char*)d_ws;
#if ONE_LAUNCH
    a.ph_lo = 0; a.ph_hi = N_PHASES;
    void* kargs[] = {&a};
    hipError_t e = hipLaunchCooperativeKernel((const void*)fwd_kernel, dim3(grid), dim3(512), kargs, LDS_BYTES, stream);
    if (e != hipSuccess) fprintf(stderr, "cooperative launch failed: %s (grid %d)\n", hipGetErrorString(e), grid);
#else
    for (int p = 0; p < N_PHASES; ++p) { a.ph_lo = p; a.ph_hi = p + 1; hipLaunchKernelGGL(fwd_kernel, dim3(grid), dim3(512), LDS_BYTES, stream, a); }
#endif
}
```

```cpp
#include <hip/hip_runtime.h>
#include <hip/hip_cooperative_groups.h>
#include <cstdio>
#include <cstdint>
namespace cg = cooperative_groups;

#ifndef ONE_LAUNCH
#define ONE_LAUNCH 1
#endif

#define LAS __attribute__((address_space(3)))
typedef unsigned short bf16_t;
typedef short bf16x8 __attribute__((ext_vector_type(8)));
typedef float f32x4 __attribute__((ext_vector_type(4)));
typedef float f32x2 __attribute__((ext_vector_type(2)));
typedef unsigned u32x4 __attribute__((ext_vector_type(4)));
typedef unsigned u32x2 __attribute__((ext_vector_type(2)));
typedef short v4i16_t __attribute__((ext_vector_type(4)));
typedef unsigned long long u64;

constexpr int DM = 1024, BATCH = 32, SEQ = 2048, M = BATCH * SEQ;
constexpr int HD = 64, AW = 384, CW = 256, LW = 384, INC = 2432, INP = 2560, FF = 4096;
constexpr int Q0 = 0, K0 = 384, V0 = 768, CA0 = 1152, CG0 = 1408, LG0 = 1664, LX0 = 2048;
constexpr float RMS_EPS = 1e-6f, LN_EPS = 1e-5f;
constexpr float LOG2E = 1.4426950408889634f, LN2 = 0.6931471805599453f;

constexpr size_t MiB = 1u << 20;
constexpr size_t WS_CTR = 0, WS_BAR = 65536;
constexpr size_t WS_CTR_UNUSED = 0;
constexpr size_t WS_W = 2 * MiB, W_LAYER = 23 * MiB;
constexpr size_t WO_IN = 0, WO_OUT = 5 * MiB, WO_UP = 7 * MiB, WO_DN = 15 * MiB;
constexpr size_t WS_SSQ = 48 * MiB;
constexpr size_t WS_LSE = 51 * MiB;
constexpr size_t WS_XB = 53 * MiB;
constexpr size_t WS_BIG = 181 * MiB;
constexpr size_t WS_Z = WS_BIG, WS_MIX = WS_BIG + 304 * MiB, WS_AO = WS_BIG + 432 * MiB;
constexpr size_t WS_Y2 = WS_BIG + 480 * MiB, WS_SUM = WS_BIG + 528 * MiB;
constexpr size_t WS_WTG = 1 * MiB;
constexpr size_t WS_END = WS_BIG + 530 * MiB;
constexpr int N_LRUC = 6 * BATCH * 16, N_ATT = BATCH * 96;

constexpr int LDS_BYTES = 151552;
constexpr int EPI_STG_OFF = 131072 + 1024, EPI_STG_SLICE = 2304;
constexpr int MISC_OFF = 131072;

__device__ __forceinline__ float bf_lo(unsigned w) { return __uint_as_float(w << 16); }
__device__ __forceinline__ float bf_hi(unsigned w) { return __uint_as_float(w & 0xffff0000u); }
__device__ __forceinline__ float bf2f(bf16_t b) { return __uint_as_float((unsigned)b << 16); }
__device__ __forceinline__ unsigned f2bf(float f) { unsigned u = __float_as_uint(f); return (u + 0x7fffu + ((u >> 16) & 1u)) >> 16; }
__device__ __forceinline__ unsigned pk2(float lo, float hi) { return f2bf(lo) | (f2bf(hi) << 16); }
__device__ __forceinline__ unsigned cvt_pk_bf16(float lo, float hi) { unsigned r; asm volatile("v_cvt_pk_bf16_f32 %0, %1, %2" : "=v"(r) : "v"(lo), "v"(hi)); return r; }
__device__ __forceinline__ float sigmoidf_(float x) { return __builtin_amdgcn_rcpf(1.f + __expf(-x)); }
__device__ __forceinline__ float wave_sum(float v) {
#pragma unroll
    for (int o = 1; o < 64; o <<= 1) v += __shfl_xor(v, o);
    return v;
}
__device__ __forceinline__ float rinv_from(u64 v) { return rsqrtf((float)v * (1.0f / 16777216.0f) * (1.0f / 1024.0f) + RMS_EPS); }

namespace pg8 {
constexpr int BM = 256, BK = 64, HALF = 128, HTB = HALF * BK * 2, STAGE_BYTES = 8 * HTB, NXCD = 8, WGM = 8;
__host__ __device__ __forceinline__ int lds_byte(int r, int c) { const int st = (r >> 4) * 2 + (c >> 5), rr = r & 15, cc = c & 31, ob = rr * 64 + cc * 2; return st * 1024 + (ob ^ (((ob >> 9) & 1) << 5)); }
__host__ __device__ __forceinline__ void stage_rc(int b, int& R, int& C) { const int st = b / 1024, sb = b % 1024, swz = sb ^ (((sb >> 9) & 1) << 5); R = (st >> 1) * 16 + swz / 64; C = (st & 1) * 32 + (swz % 64) / 2; }
__host__ __device__ __forceinline__ int perm32(int rho) { const int n = rho >> 4, i = rho & 15; return 8 * (i >> 2) + 4 * n + (i & 3); }

struct Unit { int pm, pn; };
struct Gemm { const bf16_t* A; const bf16_t* Bt; int M, N, K; };

struct StaticOrder {
    int nM, nN, nwg, G, c;
    __host__ __device__ void init(int M_, int N_, int G_, int c_) { nM = M_ / BM; nN = N_ / BM; nwg = nM * nN; G = G_; c = c_; }
    __host__ __device__ bool next(int i, Unit& u) const {
        const long L = (long)i * G + c; if (L >= nwg) return false;
        int wgid = (int)L; { const int q = nwg / NXCD, r = nwg % NXCD, xcd = wgid % NXCD, off = wgid / NXCD; wgid = (xcd < r ? xcd * (q + 1) : r * (q + 1) + (xcd - r) * q) + off; }
        const int nig = WGM * nN, gid = wgid / nig, fm = gid * WGM, gsz = (nM - fm) < WGM ? (nM - fm) : WGM;
        u.pm = fm + ((wgid % nig) % gsz); u.pn = (wgid % nig) / gsz; return true;
    }
    __device__ __forceinline__ void a_ready(const Unit&) const {}
    __device__ __forceinline__ void done(const Unit&) const {}
};

template <int ACT> struct EpiRowScale {
    static constexpr bool PERM = true, AFTER_DRAIN = false;
    bf16_t* O; int ldc; const u64* ssq; int nvalid; LAS unsigned char* stg;
    __device__ __forceinline__ void operator()(const f32x4 (&acc)[2][2][4][2], const Unit& u, int wr, int wc, int fr, int fq) const {
        const int ln = fr + 16 * fq; const int colw = u.pn * BM + 64 * wc;
        if (colw >= nvalid) return;
        float rl[2];
#pragma unroll
        for (int ai = 0; ai < 2; ++ai) rl[ai] = rinv_from(ssq[u.pm * BM + ai * HALF + wr * 64 + ln]);
        LAS unsigned char* sl = stg + (wr * 4 + wc) * EPI_STG_SLICE;
        const int rr = ln >> 3, cc = ln & 7;
#pragma unroll
        for (int ai = 0; ai < 2; ++ai)
#pragma unroll
            for (int m = 0; m < 4; ++m) {
                const float sc = __shfl(rl[ai], 16 * m + fr);
#pragma unroll
                for (int bj = 0; bj < 2; ++bj) {
                    f32x4 v0 = acc[ai][bj][m][0] * sc, v1 = acc[ai][bj][m][1] * sc;
                    if (ACT == 1) {
#pragma unroll
                        for (int e = 0; e < 4; ++e) { float a = fmaxf(v0[e], 0.f), b = fmaxf(v1[e], 0.f); v0[e] = a * a; v1[e] = b * b; }
                    }
                    u32x4 w; w.x = cvt_pk_bf16(v0[0], v0[1]); w.y = cvt_pk_bf16(v0[2], v0[3]); w.z = cvt_pk_bf16(v1[0], v1[1]); w.w = cvt_pk_bf16(v1[2], v1[3]);
                    *(LAS u32x4*)(sl + fr * 144 + bj * 64 + fq * 16) = w;
                }
                const int rowb = u.pm * BM + ai * HALF + wr * 64 + m * 16;
#pragma unroll
                for (int i = 0; i < 2; ++i) { const int r = rr + 8 * i; const u32x4 q = *(const LAS u32x4*)(sl + r * 144 + cc * 16);
                    __builtin_nontemporal_store(q, (u32x4*)(O + (size_t)(rowb + r) * ldc + colw + cc * 8)); }
            }
    }
};
struct EpiResid {
    static constexpr bool PERM = true, AFTER_DRAIN = false;
    bf16_t* xb; u64* ssq;
    __device__ __forceinline__ void operator()(const f32x4 (&acc)[2][2][4][2], const Unit& u, int wr, int wc, int fr, int fq) const {
        const int col0 = u.pn * BM + wc * 64 + 8 * fq;
#pragma unroll
        for (int ai = 0; ai < 2; ++ai) {
            u32x4 bs[4][2]; float qs[4];
#pragma unroll
            for (int m = 0; m < 4; ++m) { const size_t off = (size_t)(u.pm * BM + ai * HALF + wr * 64 + m * 16 + fr) * DM + col0;
#pragma unroll
                for (int bj = 0; bj < 2; ++bj) bs[m][bj] = *(const u32x4*)(xb + off + bj * 32); }
#pragma unroll
            for (int m = 0; m < 4; ++m) {
                const int row = u.pm * BM + ai * HALF + wr * 64 + m * 16 + fr; const size_t off = (size_t)row * DM + col0; float q = 0.f;
#pragma unroll
                for (int bj = 0; bj < 2; ++bj) {
                    const f32x4 a0 = acc[ai][bj][m][0], a1 = acc[ai][bj][m][1]; const u32x4 b4 = bs[m][bj];
                    const float o0 = bf_lo(b4.x) + a0[0], o1 = bf_hi(b4.x) + a0[1], o2 = bf_lo(b4.y) + a0[2], o3 = bf_hi(b4.y) + a0[3];
                    const float o4 = bf_lo(b4.z) + a1[0], o5 = bf_hi(b4.z) + a1[1], o6 = bf_lo(b4.w) + a1[2], o7 = bf_hi(b4.w) + a1[3];
                    q += ((o0 * o0 + o1 * o1) + (o2 * o2 + o3 * o3)) + ((o4 * o4 + o5 * o5) + (o6 * o6 + o7 * o7));
                    u32x4 w; w.x = cvt_pk_bf16(o0, o1); w.y = cvt_pk_bf16(o2, o3); w.z = cvt_pk_bf16(o4, o5); w.w = cvt_pk_bf16(o6, o7);
                    *(u32x4*)(xb + off + bj * 32) = w;
                }
                q += __shfl_xor(q, 16); q += __shfl_xor(q, 32); qs[m] = q;
            }
            { const float mine = fq == 0 ? qs[0] : (fq == 1 ? qs[1] : (fq == 2 ? qs[2] : qs[3]));
              __hip_atomic_fetch_add(ssq + (u.pm * BM + ai * HALF + wr * 64 + 16 * fq + fr), (u64)(mine * 16777216.0f), __ATOMIC_RELAXED, __HIP_MEMORY_SCOPE_AGENT); }
            asm volatile("" ::: "memory");
        }
    }
};

template <class Epi, class Sched, bool ALIGN_EPI = false, bool SP2 = false>
__device__ __forceinline__ void gemm_phase(LAS unsigned char* lds, const Gemm g, const Sched& S, const Epi& E) {
    const int tid = threadIdx.x, wid = __builtin_amdgcn_readfirstlane(tid >> 6), lane = tid & 63, wr = wid >> 2, wc = wid & 3, fr = lane & 15, fq = lane >> 4;
    const int K = g.K, nt = K / BK;
    unsigned voffA[2], voffB[2];
#pragma unroll
    for (int i = 0; i < 2; ++i) { int R, C; stage_rc(tid * 16 + i * 8192, R, C); const int Rb = Epi::PERM ? ((R & ~31) + perm32(R & 31)) : R;
        voffA[i] = (unsigned)(R * K + C) * 2u; voffB[i] = (unsigned)(Rb * K + C) * 2u; }
    const size_t kstep = (size_t)(BK * 2);
    const size_t hstep = (size_t)HALF * K * 2;
    const size_t tstep = 2 * hstep;
    const unsigned ldsw = (unsigned)wid * 1024u;
    const int aoff = lds_byte(wr * 64 + fr, fq * 8), boff = lds_byte(wc * 32 + fr, fq * 8);
#define PG8_SA(b, h) (((b) * 2 + (h)) * HTB)
#define PG8_SB(b, h) ((4 + (b) * 2 + (h)) * HTB)
#define PG8_STAGE(bufoff, gbase, voff) do { _Pragma("unroll") for (int _i = 0; _i < 2; ++_i) \
        __builtin_amdgcn_global_load_lds((const unsigned*)((const char*)(gbase) + (voff)[_i]), (LAS unsigned*)(lds + (bufoff) + ldsw + _i * 8192), 16, 0, 0); } while (0)
#define PG8_LDA(dst, b, h) do { _Pragma("unroll") for (int m = 0; m < 4; ++m) _Pragma("unroll") for (int k = 0; k < 2; ++k) dst[m][k] = *(const LAS bf16x8*)(lds + PG8_SA(b, h) + aoff + m * 2048 + k * 1024); } while (0)
#define PG8_LDB(dst, b, h) do { _Pragma("unroll") for (int n = 0; n < 2; ++n) _Pragma("unroll") for (int k = 0; k < 2; ++k) dst[n][k] = *(const LAS bf16x8*)(lds + PG8_SB(b, h) + boff + n * 2048 + k * 1024); } while (0)
#define PG8_MMA(ai, bj, At, Bt) do { __builtin_amdgcn_s_setprio(1); _Pragma("unroll") for (int m = 0; m < 4; ++m) _Pragma("unroll") for (int n = 0; n < 2; ++n) _Pragma("unroll") for (int k = 0; k < 2; ++k) \
        acc[ai][bj][m][n] = __builtin_amdgcn_mfma_f32_16x16x32_bf16(Bt[n][k], At[m][k], acc[ai][bj][m][n], 0, 0, 0); __builtin_amdgcn_s_setprio(0); } while (0)
#define PG8_WAIT_V(n) asm volatile("s_waitcnt vmcnt(" #n ")" ::: "memory")
#define PG8_WAIT_L(n) asm volatile("s_waitcnt lgkmcnt(" #n ")" ::: "memory")
#define PG8_BAR __builtin_amdgcn_s_barrier()
#define PG8_SCHED __builtin_amdgcn_sched_barrier(0)
    Unit cur, nxt; int ui = 0;
    if (!S.next(0, cur)) return;
    f32x4 acc[2][2][4][2];
#pragma unroll
    for (int a = 0; a < 2; ++a)
#pragma unroll
        for (int b = 0; b < 2; ++b)
#pragma unroll
            for (int m = 0; m < 4; ++m)
#pragma unroll
                for (int n = 0; n < 2; ++n) acc[a][b][m][n] = (f32x4){0.f, 0.f, 0.f, 0.f};
    bf16x8 At[4][2], B0[2][2], B1[2][2];
    const char* cA = (const char*)g.A + (size_t)cur.pm * tstep; const char* cB = (const char*)g.Bt + (size_t)cur.pn * tstep;
    S.a_ready(cur);
    if constexpr (SP2) {
        PG8_STAGE(PG8_SB(0, 0), cB, voffB); PG8_STAGE(PG8_SB(0, 1), cB + hstep, voffB); PG8_STAGE(PG8_SA(0, 0), cA, voffA); PG8_STAGE(PG8_SA(0, 1), cA + hstep, voffA);
        if (wr == 1) PG8_BAR;
        PG8_WAIT_V(2); PG8_BAR;
        PG8_STAGE(PG8_SB(1, 0), cB + kstep, voffB); PG8_STAGE(PG8_SA(1, 0), cA + kstep, voffA); PG8_STAGE(PG8_SB(1, 1), cB + hstep + kstep, voffB);
        PG8_WAIT_V(6); PG8_BAR;
    } else {
        PG8_STAGE(PG8_SB(0, 0), cB, voffB); PG8_STAGE(PG8_SA(0, 0), cA, voffA); PG8_STAGE(PG8_SB(0, 1), cB + hstep, voffB); PG8_STAGE(PG8_SA(0, 1), cA + hstep, voffA);
        if (wr == 1) PG8_BAR;
        PG8_WAIT_V(4); PG8_BAR;
        PG8_STAGE(PG8_SB(1, 0), cB + kstep, voffB); PG8_STAGE(PG8_SA(1, 0), cA + kstep, voffA); PG8_STAGE(PG8_SB(1, 1), cB + hstep + kstep, voffB);
        PG8_WAIT_V(6); PG8_BAR;
    }
    for (;;) {
        const bool has_next = S.next(ui + 1, nxt);
        const char* nA = has_next ? (const char*)g.A + (size_t)nxt.pm * tstep : cA; const char* nB = has_next ? (const char*)g.Bt + (size_t)nxt.pn * tstep : cB;
        for (int t = 0; t < nt; t += 2) {
            const bool last = (t == nt - 2);
            const char* a1 = cA + (size_t)(t + 1) * kstep;
            const char* a2 = last ? nA : cA + (size_t)(t + 2) * kstep; const char* b2 = last ? nB : cB + (size_t)(t + 2) * kstep;
            const char* a3 = a2 + kstep; const char* b3 = b2 + kstep;
            if (last && has_next) S.a_ready(nxt);
            if constexpr (SP2) {
            PG8_LDB(B0, 0, 0); PG8_LDB(B1, 0, 1); PG8_SCHED; PG8_LDA(At, 0, 0); PG8_STAGE(PG8_SA(1, 1), a1 + hstep, voffA);
            PG8_WAIT_V(8); PG8_WAIT_L(0); PG8_BAR; PG8_MMA(0, 0, At, B0); PG8_MMA(0, 1, At, B1); PG8_BAR; PG8_SCHED;
            PG8_LDA(At, 0, 1); PG8_STAGE(PG8_SB(0, 0), b2, voffB); PG8_STAGE(PG8_SB(0, 1), b2 + hstep, voffB); PG8_STAGE(PG8_SA(0, 0), a2, voffA);
            PG8_WAIT_V(8); PG8_WAIT_L(0); PG8_BAR; PG8_MMA(1, 0, At, B0); PG8_MMA(1, 1, At, B1); PG8_BAR; PG8_SCHED;
            PG8_LDB(B0, 1, 0); PG8_LDB(B1, 1, 1); PG8_SCHED; PG8_LDA(At, 1, 0); PG8_STAGE(PG8_SA(0, 1), a2 + hstep, voffA);
            PG8_WAIT_V(8); PG8_WAIT_L(0); PG8_BAR; PG8_MMA(0, 0, At, B0); PG8_MMA(0, 1, At, B1); PG8_BAR; PG8_SCHED;
            PG8_LDA(At, 1, 1); PG8_STAGE(PG8_SB(1, 0), b3, voffB); PG8_STAGE(PG8_SB(1, 1), b3 + hstep, voffB); PG8_STAGE(PG8_SA(1, 0), a3, voffA);
            PG8_WAIT_V(8); PG8_WAIT_L(0); PG8_BAR; PG8_MMA(1, 0, At, B0); PG8_MMA(1, 1, At, B1); PG8_BAR; PG8_SCHED;
            } else {
            PG8_LDB(B0, 0, 0); PG8_SCHED; PG8_LDA(At, 0, 0); PG8_STAGE(PG8_SA(1, 1), a1 + hstep, voffA);
            PG8_WAIT_L(8); PG8_BAR; PG8_WAIT_L(0); PG8_MMA(0, 0, At, B0); PG8_BAR; PG8_SCHED;
            PG8_LDB(B1, 0, 1); PG8_STAGE(PG8_SB(0, 0), b2, voffB);
            PG8_BAR; PG8_WAIT_L(0); PG8_MMA(0, 1, At, B1); PG8_BAR;
            PG8_LDA(At, 0, 1); PG8_STAGE(PG8_SA(0, 0), a2, voffA);
            PG8_BAR; PG8_WAIT_L(0); PG8_MMA(1, 0, At, B0); PG8_BAR; PG8_SCHED;
            PG8_STAGE(PG8_SB(0, 1), b2 + hstep, voffB);
            PG8_WAIT_V(6); PG8_BAR; PG8_MMA(1, 1, At, B1); PG8_BAR;
            PG8_LDB(B0, 1, 0); PG8_SCHED; PG8_LDA(At, 1, 0); PG8_STAGE(PG8_SA(0, 1), a2 + hstep, voffA);
            PG8_WAIT_L(8); PG8_BAR; PG8_WAIT_L(0); PG8_MMA(0, 0, At, B0); PG8_BAR; PG8_SCHED;
            PG8_LDB(B1, 1, 1); PG8_STAGE(PG8_SB(1, 0), b3, voffB);
            PG8_BAR; PG8_WAIT_L(0); PG8_MMA(0, 1, At, B1); PG8_BAR;
            PG8_LDA(At, 1, 1); PG8_STAGE(PG8_SA(1, 0), a3, voffA);
            PG8_BAR; PG8_WAIT_L(0); PG8_MMA(1, 0, At, B0); PG8_BAR; PG8_SCHED;
            PG8_STAGE(PG8_SB(1, 1), b3 + hstep, voffB);
            PG8_WAIT_V(6); PG8_BAR; PG8_MMA(1, 1, At, B1); PG8_BAR;
            }
        }
        if constexpr (ALIGN_EPI) { if (wr == 0) PG8_BAR; }
        if constexpr (!Epi::AFTER_DRAIN) { E(acc, cur, wr, wc, fr, fq); S.done(cur); }
        if (!has_next) break;
#pragma unroll
        for (int a = 0; a < 2; ++a)
#pragma unroll
            for (int b = 0; b < 2; ++b)
#pragma unroll
                for (int m = 0; m < 4; ++m)
#pragma unroll
                    for (int n = 0; n < 2; ++n) acc[a][b][m][n] = (f32x4){0.f, 0.f, 0.f, 0.f};
        cur = nxt; cA = nA; cB = nB; ++ui;
        if constexpr (ALIGN_EPI) { if (wr == 1) PG8_BAR; }
    }
    PG8_WAIT_V(0);
    if constexpr (!ALIGN_EPI) { if (wr == 0) PG8_BAR; }
    PG8_BAR;
#undef PG8_SA
#undef PG8_SB
#undef PG8_STAGE
#undef PG8_LDA
#undef PG8_LDB
#undef PG8_MMA
#undef PG8_WAIT_V
#undef PG8_WAIT_L
#undef PG8_BAR
#undef PG8_SCHED
}
}

typedef __attribute__((address_space(1))) unsigned char gchar_t;
__device__ __forceinline__ unsigned char* launder(unsigned char* p) { size_t z = 0; asm volatile("" : "+s"(z)); return p + z; }
__device__ __forceinline__ const float* gptr(const float* p) { return (const float*)(const __attribute__((address_space(1))) float*)p; }
__device__ __forceinline__ int launder_v(int x) { asm volatile("" : "+v"(x)); return x; }

#define XB_TMO      128
#define XB_XCNT(j)  (256  + 64 * (j))
#define XB_XSUB(j)  (1280 + 64 * (j))
#define XB_XGEN(j)  (2304 + 64 * (j))
#define XB_TOP      3328
#define XB_TOPGEN   3392
#define XCD_BAR_WORDS 3456
#define XB_SPIN_CAP (1u << 18)
__device__ __forceinline__ unsigned xb_ld(unsigned* p)              { return __hip_atomic_load(p, __ATOMIC_RELAXED, __HIP_MEMORY_SCOPE_AGENT); }
__device__ __forceinline__ unsigned xb_add(unsigned* p, unsigned v) { return __hip_atomic_fetch_add(p, v, __ATOMIC_RELAXED, __HIP_MEMORY_SCOPE_AGENT); }
__device__ __forceinline__ unsigned xb_xcc_id() { return (unsigned)__builtin_amdgcn_s_getreg((3 << 11) | 20) & 0xFu; }
#define XB_SPIN(cond, bar) do { unsigned _sp = 0; while (cond) { __builtin_amdgcn_s_sleep(1); \
    if ((++_sp & 255u) == 0u) { if (xb_ld(&(bar)[XB_TMO])) break; if (_sp > XB_SPIN_CAP) { atomicAdd(&(bar)[XB_TMO], 1u); break; } } } } while (0)
struct XcdBarrier { unsigned* bar; unsigned x; volatile LAS unsigned* st; };
__device__ __forceinline__ XcdBarrier xcd_barrier_post(unsigned* bar, volatile LAS unsigned* st) {
    XcdBarrier b; b.bar = bar; b.x = xb_xcc_id(); b.st = st;
    if (threadIdx.x == 0) (void)xb_add(&bar[XB_XCNT(b.x)], 1u);
    return b;
}
__device__ __forceinline__ void xcd_barrier_complete(unsigned* bar, unsigned x, unsigned& nloc, unsigned& nx) {
    const unsigned G = gridDim.x * gridDim.y * gridDim.z;
    unsigned sum, cnt, mine, sp = 0u;
    for (;;) {
        sum = 0u; cnt = 0u; mine = 0u;
#pragma unroll
        for (unsigned j = 0; j < 16; ++j) { const unsigned c = xb_ld(&bar[XB_XCNT(j)]); sum += c; cnt += (c > 0u) ? 1u : 0u; mine = (j == x) ? c : mine; }
        if (sum == G) break;
        __builtin_amdgcn_s_sleep(1);
        if ((++sp & 255u) == 0u) { if (xb_ld(&bar[XB_TMO])) break; if (sp > XB_SPIN_CAP) { atomicAdd(&bar[XB_TMO], 1u); break; } }
    }
    nloc = mine > 0u ? mine : 1u; nx = cnt > 0u ? cnt : 1u;
}
__device__ __forceinline__ void xcd_barrier(const XcdBarrier& b) {
    asm volatile("s_waitcnt vmcnt(0)" ::: "memory");
    __syncthreads();
    if (threadIdx.x == 0) {
        unsigned* bar = b.bar;
        __builtin_amdgcn_s_waitcnt(0);
        unsigned nloc = b.st[0], nx = b.st[1];
        if (nloc == 0u) { xcd_barrier_complete(bar, b.x, nloc, nx); b.st[0] = nloc; b.st[1] = nx; }
        const unsigned old = xb_add(&bar[XB_XSUB(b.x)], 1u);
        const unsigned gen = old / nloc;
        if (old + 1u == (gen + 1u) * nloc) {
            __builtin_amdgcn_fence(__ATOMIC_RELEASE, "agent");
            asm volatile("s_waitcnt vmcnt(0)" ::: "memory");
            const unsigned og = xb_add(&bar[XB_TOP], 1u);
            const unsigned tg = og / nx;
            if (og + 1u == (tg + 1u) * nx) xb_add(&bar[XB_TOPGEN], 1u);
            else XB_SPIN(xb_ld(&bar[XB_TOPGEN]) == tg, bar);
            __builtin_amdgcn_fence(__ATOMIC_ACQUIRE, "agent");
            xb_add(&bar[XB_XGEN(b.x)], 1u);
            asm volatile("s_waitcnt vmcnt(0)" ::: "memory");
        } else {
            XB_SPIN(xb_ld(&bar[XB_XGEN(b.x)]) == gen, bar);
            __builtin_amdgcn_fence(__ATOMIC_ACQUIRE, "agent");
            asm volatile("s_waitcnt vmcnt(0)" ::: "memory");
        }
    }
    __syncthreads();
}
struct Args { const float* in[19]; float* out; unsigned char* ws; int ph_lo, ph_hi; };

struct Ctx {
    const float* const* in; float* out; unsigned char* ws;
    LAS unsigned char* lds; int tid, lane, wave, G, bid;
};

__host__ __device__ __forceinline__ int wrow(int n) { return (n & ~255) | (((n >> 5) & 1) << 7) | (((n >> 6) & 3) << 5) | (n & 31); }
__device__ __forceinline__ void tr_item(const float* W, int K, int N, bf16_t* WT, const float* gs, LAS float* scr, int item, int lane) {
    const int nblk = N / 32, kb = item / nblk, nb = item % nblk, k0 = 64 * kb, n0 = 32 * nb;
    const int c4 = (lane & 7) * 4;
#pragma unroll
    for (int i = 0; i < 8; ++i) { const int kk = 8 * i + (lane >> 3); const float s = gs ? gs[k0 + kk] : 1.f; const f32x4 v = *(const f32x4*)(W + (size_t)(k0 + kk) * N + n0 + c4) * s;
        LAS float* d = scr + kk * 33 + c4; d[0] = v[0]; d[1] = v[1]; d[2] = v[2]; d[3] = v[3]; }
    asm volatile("s_waitcnt lgkmcnt(0)" ::: "memory");
    const int c = lane & 7;
#pragma unroll
    for (int j = 0; j < 4; ++j) { const int n = (lane >> 3) + 8 * j; const LAS float* s = scr + (8 * c) * 33 + n;
        u32x4 o; o.x = pk2(s[0 * 33], s[1 * 33]); o.y = pk2(s[2 * 33], s[3 * 33]); o.z = pk2(s[4 * 33], s[5 * 33]); o.w = pk2(s[6 * 33], s[7 * 33]);
        *(u32x4*)(WT + (size_t)wrow(n0 + n) * K + k0 + 8 * c) = o; }
    asm volatile("s_waitcnt lgkmcnt(0)" ::: "memory");
}

__device__ __forceinline__ void prologue(const Ctx& C) {
    const int gw = C.bid * 8 + C.wave, NGW = C.G * 8; const int gt = C.bid * 512 + C.tid, NGT = C.G * 512;
    { u64* s = (u64*)(C.ws + WS_SSQ) + M; for (int i = gt; i < 4 * M; i += NGT) s[i] = 0ull;
      unsigned* ctr = (unsigned*)(C.ws + WS_CTR); if (gt < 64) ctr[gt] = 0u;
      unsigned* barw = (unsigned*)(C.ws + WS_BAR); if (gt < 3456) barw[gt] = 0u;
      for (int l = 0; l < 2; ++l) { bf16_t* wt = (bf16_t*)(C.ws + WS_W + l * W_LAYER + WO_IN); for (int i = gt; i < (INP - INC) * DM / 8; i += NGT) { const int n = INC + i / (DM / 8), ch = i % (DM / 8); *(u32x4*)(wt + (size_t)wrow(n) * DM + ch * 8) = (u32x4){0u, 0u, 0u, 0u}; } } }
    { bf16_t* wtg = (bf16_t*)(C.ws + WS_WTG);
      for (int i = gt; i < 2 * 6 * 2 * 4096; i += NGT) { const int o = i & 63, k = (i >> 6) & 63, mat = (i >> 12) & 1, lh = i >> 13;
          const float v = (mat ? gptr(C.in[11]) : gptr(C.in[9]))[(size_t)lh * 4096 + k * 64 + o]; wtg[((size_t)(lh * 2 + mat) * 64 + o) * 64 + k] = (bf16_t)f2bf(v); } }
    LAS float* scr = (LAS float*)(C.lds + C.wave * 16384);
    constexpr int I_IN = (DM / 64) * (INC / 32), I_OUT = (DM / 64) * (DM / 32), I_UP = (DM / 64) * (FF / 32), I_DN = (FF / 64) * (DM / 32), I_L = I_IN + I_OUT + I_UP + I_DN;
    for (int it = gw; it < 2 * I_L; it += NGW) {
        const int l = it / I_L; int r = it % I_L; unsigned char* wb = C.ws + WS_W + l * W_LAYER;
        if (r < I_IN) { tr_item(gptr(C.in[2]) + (size_t)l * DM * INC, DM, INC, (bf16_t*)(wb + WO_IN), gptr(C.in[1]) + l * DM, scr, r, C.lane); continue; } r -= I_IN;
        if (r < I_OUT) { tr_item(gptr(C.in[14]) + (size_t)l * DM * DM, DM, DM, (bf16_t*)(wb + WO_OUT), nullptr, scr, r, C.lane); continue; } r -= I_OUT;
        if (r < I_UP) { tr_item(gptr(C.in[16]) + (size_t)l * DM * FF, DM, FF, (bf16_t*)(wb + WO_UP), gptr(C.in[15]) + l * DM, scr, r, C.lane); continue; } r -= I_UP;
        tr_item(gptr(C.in[17]) + (size_t)l * FF * DM, FF, DM, (bf16_t*)(wb + WO_DN), nullptr, scr, r, C.lane);
    }
    const float* x = gptr(C.in[0]); bf16_t* xb = (bf16_t*)(C.ws + WS_XB); u64* ssq0 = (u64*)(C.ws + WS_SSQ);
    for (int m0 = gw * 4; m0 < M; m0 += NGW * 4) {
        f32x4 v[4][4]; float sq[4];
#pragma unroll
        for (int r = 0; r < 4; ++r) { const f32x4* xr = (const f32x4*)(x + (size_t)(m0 + r) * DM) + 2 * C.lane;
#pragma unroll
            for (int j = 0; j < 2; ++j) { v[r][2 * j] = xr[128 * j]; v[r][2 * j + 1] = xr[128 * j + 1]; } }
#pragma unroll
        for (int r = 0; r < 4; ++r) { float s = 0.f;
#pragma unroll
            for (int j = 0; j < 4; ++j) s += (v[r][j].x * v[r][j].x + v[r][j].y * v[r][j].y) + (v[r][j].z * v[r][j].z + v[r][j].w * v[r][j].w);
            sq[r] = wave_sum(s); }
#pragma unroll
        for (int r = 0; r < 4; ++r) {
            if (C.lane == 0) ssq0[m0 + r] = (u64)(sq[r] * 16777216.0f);
            u32x4* o16 = (u32x4*)(xb + (size_t)(m0 + r) * DM) + C.lane;
#pragma unroll
            for (int j = 0; j < 2; ++j) { u32x4 w; w.x = pk2(v[r][2 * j].x, v[r][2 * j].y); w.y = pk2(v[r][2 * j].z, v[r][2 * j].w); w.z = pk2(v[r][2 * j + 1].x, v[r][2 * j + 1].y); w.w = pk2(v[r][2 * j + 1].z, v[r][2 * j + 1].w); o16[64 * j] = w; } }
    }
}

struct MixCtx { const bf16_t* Z; bf16_t* MIX; bf16_t* AO; float* LSE; bf16_t* Y2; float* SUM; const bf16_t* WTG; const float* const* in; int l; };
__device__ __forceinline__ MixCtx mk_mix(unsigned char* ws, const float* const* in, int l) { ws = launder(ws); asm volatile("" : "+s"(l));
    MixCtx X; X.Z = (const bf16_t*)(ws + WS_Z); X.MIX = (bf16_t*)(ws + WS_MIX); X.AO = (bf16_t*)(ws + WS_AO); X.LSE = (float*)(ws + WS_LSE); X.Y2 = (bf16_t*)(ws + WS_Y2); X.SUM = (float*)(ws + WS_SUM); X.WTG = (const bf16_t*)(ws + WS_WTG); X.in = in; X.l = l; return X; }

struct AttnPre { u32x4 k[4], v[4]; bf16x8 q0, q1; };
__device__ __forceinline__ void attn_load(const bf16_t* Z, int a, int tid, AttnPre& P) {
    const int lane = tid & 63, w = tid >> 6;
    const int b = a / 96, rem = a % 96, h = rem >> 4, u16 = rem & 15;
    const int sh = 2 * (h >> 1), dil = 1 << sh, nbm = (16 >> sh) - 1;
    const int r = u16 >> (4 - sh), n = u16 & nbm;
    const bf16_t* zb = Z + (size_t)b * SEQ * INC;
#pragma unroll
    for (int i = 0; i < 4; ++i) { const int c = tid + 512 * i; const int row = c >> 3, ch = c & 7; const int sub = (n - 1) * 128 + row;
        P.k[i] = (u32x4){0u, 0u, 0u, 0u}; P.v[i] = (u32x4){0u, 0u, 0u, 0u};
        if (sub >= 0) { const size_t off = (size_t)(sub * dil + r) * INC + h * 64 + ch * 8; P.k[i] = *(const u32x4*)(zb + off + K0); P.v[i] = *(const u32x4*)(zb + off + V0); } }
    const int j = lane & 15, kq = lane >> 4; const int qi = 16 * w + j; const int qpos = (n * 128 + qi) * dil + r;
    const bf16_t* qp = zb + (size_t)qpos * INC + Q0 + h * 64 + kq * 8;
    P.q0 = *(const bf16x8*)qp; P.q1 = *(const bf16x8*)(qp + 32);
}
__device__ __forceinline__ void attn_compute(const MixCtx& X, int a, LAS unsigned char* lds, int tid, const bf16x8 q0, const bf16x8 q1) {
    const int lane = tid & 63, w = __builtin_amdgcn_readfirstlane(tid >> 6);
    const int b = a / 96, rem = a % 96, h = rem >> 4, u16 = rem & 15;
    const int sh = 2 * (h >> 1), dil = 1 << sh, nbm = (16 >> sh) - 1;
    const int r = u16 >> (4 - sh), n = u16 & nbm;
    const float slope = exp2f(-8.0f * (float)(h + 1) / 6.0f);
    const float c1 = 0.125f * LOG2E, c2 = slope * (float)dil * LOG2E;
    LAS unsigned char* Kl = lds; LAS unsigned char* Vl = lds + 39168;
    const int j = lane & 15, kq = lane >> 4;
    const int qi = 16 * w + j; const int qpos = (n * 128 + qi) * dil + r;
    float s[9][4]; float mx = -1e30f;
    const int d0 = j + 128 - 4 * kq;
    float be[4]; const float bstep = 16.0f * c2;
#pragma unroll
    for (int e = 0; e < 4; ++e) be[e] = -c2 * (float)(d0 - e);
    const int nlive0 = (n == 0) ? (8 - w) : 0;
#pragma unroll
    for (int tt = 0; tt < 9; ++tt) {
        if (tt >= nlive0) {
            const int kt = w + tt; const LAS unsigned char* p = Kl + (16 * kt + j) * 144 + kq * 16;
            const bf16x8 k0f = *(const LAS bf16x8*)p, k1f = *(const LAS bf16x8*)(p + 64);
            f32x4 acc = (f32x4){0.f, 0.f, 0.f, 0.f};
            acc = __builtin_amdgcn_mfma_f32_16x16x32_bf16(k0f, q0, acc, 0, 0, 0);
            acc = __builtin_amdgcn_mfma_f32_16x16x32_bf16(k1f, q1, acc, 0, 0, 0);
#pragma unroll
            for (int e = 0; e < 4; ++e) {
                float v = acc[e] * c1 + (be[e] + bstep * (float)tt);
                if (tt == 0) { if (d0 - e > 128) v = -1e30f; }
                if (tt == 8) { if (d0 - 128 - e < 0) v = -1e30f; }
                s[tt][e] = v; mx = fmaxf(mx, v); }
        } else {
#pragma unroll
            for (int e = 0; e < 4; ++e) s[tt][e] = -1e30f;
        }
    }
    mx = fmaxf(mx, __shfl_xor(mx, 16)); mx = fmaxf(mx, __shfl_xor(mx, 32));
    float l = 0.f;
#pragma unroll
    for (int tt = 0; tt < 9; ++tt) {
        if (tt >= nlive0) {
#pragma unroll
            for (int e = 0; e < 4; ++e) { const float pv = __builtin_amdgcn_exp2f(s[tt][e] - mx); s[tt][e] = pv; l += pv; }
        } else {
#pragma unroll
            for (int e = 0; e < 4; ++e) s[tt][e] = 0.f;
        }
    }
    l += __shfl_xor(l, 16); l += __shfl_xor(l, 32);
    f32x4 o[4];
#pragma unroll
    for (int dt = 0; dt < 4; ++dt) o[dt] = (f32x4){0.f, 0.f, 0.f, 0.f};
    const int qq = (lane & 15) >> 2, pp = lane & 3;
#pragma unroll
    for (int c = 0; c < 5; ++c) {
        if (2 * c + 1 >= nlive0) {
            u32x4 pw; pw.x = cvt_pk_bf16(s[2 * c][0], s[2 * c][1]); pw.y = cvt_pk_bf16(s[2 * c][2], s[2 * c][3]);
            if (c < 4) { pw.z = cvt_pk_bf16(s[2 * c + 1][0], s[2 * c + 1][1]); pw.w = cvt_pk_bf16(s[2 * c + 1][2], s[2 * c + 1][3]); } else { pw.z = 0u; pw.w = 0u; }
            const bf16x8 pb = __builtin_bit_cast(bf16x8, pw);
            const int row = 16 * (w + 2 * c) + 4 * kq + qq;
#pragma unroll
            for (int dt = 0; dt < 4; ++dt) {
                LAS unsigned char* vp = Vl + row * 160 + (16 * dt + 4 * pp) * 2;
                const v4i16_t lo = __builtin_amdgcn_ds_read_tr16_b64_v4i16((LAS v4i16_t*)vp);
                const v4i16_t hi = __builtin_amdgcn_ds_read_tr16_b64_v4i16((LAS v4i16_t*)(vp + 16 * 160));
                const bf16x8 vf = (bf16x8){lo[0], lo[1], lo[2], lo[3], hi[0], hi[1], hi[2], hi[3]};
                o[dt] = __builtin_amdgcn_mfma_f32_16x16x32_bf16(vf, pb, o[dt], 0, 0, 0);
            }
        }
    }
    const float inv = 1.0f / l;
    bf16_t* op = X.AO + ((size_t)b * SEQ + qpos) * AW + h * 64 + 4 * kq;
#pragma unroll
    for (int dt = 0; dt < 4; ++dt) { u32x2 wv; wv.x = cvt_pk_bf16(o[dt][0] * inv, o[dt][1] * inv); wv.y = cvt_pk_bf16(o[dt][2] * inv, o[dt][3] * inv); *(u32x2*)(op + 16 * dt) = wv; }
    if (kq == 0) X.LSE[((size_t)b * SEQ + qpos) * 6 + h] = (mx + __log2f(l)) * LN2;
}
__device__ __forceinline__ void attn_loop(unsigned char* ws_, const float* const* in_, int l_, LAS unsigned char* lds, int tid, int a_start, int a_cnt, int a_stride) {
    const MixCtx X = mk_mix(ws_, in_, l_); tid = launder_v(tid);
    LAS unsigned char* Kl = lds; LAS unsigned char* Vl = lds + 39168;
    if (tid < 128) { const int row = 256 + (tid >> 3), ch = tid & 7; const unsigned z = (unsigned)launder_v(0); const u32x4 zz = (u32x4){z, z, z, z}; *(LAS u32x4*)(Kl + row * 144 + ch * 16) = zz; *(LAS u32x4*)(Vl + row * 160 + ch * 16) = zz; }
    AttnPre P; int a = a_start;
    if (a_cnt > 0) attn_load(X.Z, a, tid, P);
    for (int k = 0; k < a_cnt; ++k, a += a_stride) {
        __syncthreads();
#pragma unroll
        for (int i = 0; i < 4; ++i) { const int c = tid + 512 * i; const int row = c >> 3, ch = c & 7;
            *(LAS u32x4*)(Kl + row * 144 + ch * 16) = P.k[i]; *(LAS u32x4*)(Vl + row * 160 + ch * 16) = P.v[i]; }
        const bf16x8 q0 = P.q0, q1 = P.q1;
        __syncthreads();
        if (k + 1 < a_cnt) attn_load(X.Z, a + a_stride, tid, P);
        attn_compute(X, a, lds, tid, q0, q1);
    }
    __syncthreads();
}

__device__ __forceinline__ void conv_glu8(const u32x4 av, const u32x4 gv, f32x4& u0, f32x4& u1) {
    u0[0] = bf_lo(av.x) * sigmoidf_(bf_lo(gv.x)); u0[1] = bf_hi(av.x) * sigmoidf_(bf_hi(gv.x)); u0[2] = bf_lo(av.y) * sigmoidf_(bf_lo(gv.y)); u0[3] = bf_hi(av.y) * sigmoidf_(bf_hi(gv.y));
    u1[0] = bf_lo(av.z) * sigmoidf_(bf_lo(gv.z)); u1[1] = bf_hi(av.z) * sigmoidf_(bf_hi(gv.z)); u1[2] = bf_lo(av.w) * sigmoidf_(bf_lo(gv.w)); u1[3] = bf_hi(av.w) * sigmoidf_(bf_hi(gv.w));
}
__device__ __forceinline__ int ring94(int r) { return r >= 94 ? r - 94 : r; }
template <int S> struct ConvStep {
    static __device__ __forceinline__ void run(float (&acc)[32], const float (&wv)[31], const LAS float* U, int rb, int cch) {
        const float uv = U[ring94(ring94(rb + S)) * 256 + cch];
#pragma unroll
        for (int o = 0; o < 32; ++o) { constexpr int dummy = 0; const int kk = S - o + dummy; if (kk >= 0 && kk <= 30) acc[o] += wv[kk] * uv; }
        ConvStep<S + 1>::run(acc, wv, U, rb, cch);
    }
};
template <> struct ConvStep<62> { static __device__ __forceinline__ void run(float (&)[32], const float (&)[31], const LAS float*, int, int) {} };
__device__ __forceinline__ void conv_loop(unsigned char* ws_, const float* const* in_, int l_, LAS unsigned char* lds, int tid, int bid, int G) {
    const MixCtx X = mk_mix(ws_, in_, l_); tid = launder_v(tid);
    const int lane = tid & 63, w = tid >> 6;
    LAS float* U = (LAS float*)lds;
    const int cch = tid & 255, half = tid >> 8;
    const float* cw = gptr(X.in[3]) + (size_t)X.l * 31 * CW; float wv[31]; int cwo = cch;
#pragma unroll
    for (int k = 0; k < 31; ++k) { wv[k] = cw[cwo]; cwo += CW; asm volatile("" : "+v"(cwo)); }
    const float bias = gptr(X.in[4])[X.l * CW + cch];
    const f32x4 gg = *(const f32x4*)(gptr(X.in[5]) + X.l * CW + 4 * lane), bb = *(const f32x4*)(gptr(X.in[6]) + X.l * CW + 4 * lane);
    for (int cc = bid; cc < BATCH * 8; cc += G) {
        const int b = cc >> 3, tb = (cc & 7) * 4;
        const bf16_t* zb = X.Z + (size_t)b * SEQ * INC;
        u32x4 pa[4], pg[4];
#pragma unroll
        for (int i = 0; i < 4; ++i) { const int idx = tid + 512 * i; const int row = idx >> 5, ch = idx & 31; const size_t t = (size_t)(tb * 64 + row);
            pa[i] = *(const u32x4*)(zb + t * INC + CA0 + ch * 8); pg[i] = *(const u32x4*)(zb + t * INC + CG0 + ch * 8); }
        __syncthreads();
#pragma unroll
        for (int i = 0; i < 2; ++i) { const int idx = tid + 512 * i; if (idx < 30 * 32) { const int row = idx >> 5, ch = idx & 31; const int t = tb * 64 - 30 + row;
            f32x4 u0 = (f32x4){0.f, 0.f, 0.f, 0.f}, u1 = u0;
            if (t >= 0) { const u32x4 av = *(const u32x4*)(zb + (size_t)t * INC + CA0 + ch * 8), gv = *(const u32x4*)(zb + (size_t)t * INC + CG0 + ch * 8); conv_glu8(av, gv, u0, u1); }
            *(LAS f32x4*)(U + row * 256 + ch * 8) = u0; *(LAS f32x4*)(U + row * 256 + ch * 8 + 4) = u1; } }
        int base = 0;
        for (int k = 0; k < 4; ++k) {
            const int t0 = (tb + k) * 64;
#pragma unroll
            for (int i = 0; i < 4; ++i) { const int idx = tid + 512 * i; const int row = ring94(base + 30 + (idx >> 5)), ch = idx & 31; f32x4 u0, u1; conv_glu8(pa[i], pg[i], u0, u1);
                *(LAS f32x4*)(U + row * 256 + ch * 8) = u0; *(LAS f32x4*)(U + row * 256 + ch * 8 + 4) = u1; }
            __syncthreads();
            if (k < 3) {
#pragma unroll
                for (int i = 0; i < 4; ++i) { const int idx = tid + 512 * i; const int row = idx >> 5, ch = idx & 31; const size_t t = (size_t)(t0 + 64 + row);
                    pa[i] = *(const u32x4*)(zb + t * INC + CA0 + ch * 8); pg[i] = *(const u32x4*)(zb + t * INC + CG0 + ch * 8); }
            }
            float acc[32];
#pragma unroll
            for (int o = 0; o < 32; ++o) acc[o] = bias;
            const int rb = base + 32 * half;
            ConvStep<0>::run(acc, wv, U, rb, cch);
            __syncthreads();
#pragma unroll
            for (int o = 0; o < 32; ++o) U[ring94(ring94(rb + o)) * 256 + cch] = acc[o];
            __syncthreads();
#pragma unroll
            for (int i = 0; i < 8; ++i) { const int tok = 8 * w + i; f32x4 v = *(LAS f32x4*)(U + ring94(base + tok) * 256 + 4 * lane);
                const float mean = wave_sum((v[0] + v[1]) + (v[2] + v[3])) * (1.0f / 256.0f);
                v = v - mean; const float var = wave_sum((v[0] * v[0] + v[1] * v[1]) + (v[2] * v[2] + v[3] * v[3])) * (1.0f / 256.0f);
                const float rstd = rsqrtf(var + LN_EPS); f32x4 y = v * rstd * gg + bb;
#pragma unroll
                for (int e = 0; e < 4; ++e) y[e] = y[e] * sigmoidf_(y[e]);
                u32x2 wv2; wv2.x = cvt_pk_bf16(y[0], y[1]); wv2.y = cvt_pk_bf16(y[2], y[3]);
                *(u32x2*)(X.MIX + ((size_t)b * SEQ + t0 + tok) * DM + AW + 4 * lane) = wv2; }
            __syncthreads();
            base = ring94(base + 64);
        }
    }
}

constexpr int LR_UB = 0, LR_A = 18432, LR_B = 53248, LR_WT = 88064, LR_PRM = 106496, LR_SA = 107264, LR_SB = 109312, LR_GT = 111360, LR_CAR = 129792;
__device__ __forceinline__ float gelu_tanh(float x) { const float y = 0.7978845608028654f * (x + 0.044715f * x * x * x); const float e = __expf(2.f * y); return 0.5f * x * (2.f - 2.f * __builtin_amdgcn_rcpf(1.f + e)); }
struct LruPre { u32x4 x[5], g[2]; };
__device__ __forceinline__ void lru_load(const MixCtx& X, int b, int h, int chunk, int tid, LruPre& P) {
    const int c0 = h * 64, t0 = chunk * 128;
    const bf16_t* zb = X.Z + (size_t)b * SEQ * INC; const int cg8 = tid & 7, tp = tid >> 3;
#pragma unroll
    for (int rr = 0; rr < 5; ++rr) { const int t = t0 + 2 * tp - 3 + rr; P.x[rr] = (u32x4){0u, 0u, 0u, 0u}; if (t >= 0) P.x[rr] = *(const u32x4*)(zb + (size_t)t * INC + LX0 + c0 + 8 * cg8); }
#pragma unroll
    for (int i = 0; i < 2; ++i) { const int idx = tid + 512 * i; const int row = idx >> 3, ch = idx & 7;
        P.g[i] = *(const u32x4*)(zb + (size_t)(t0 + row) * INC + LG0 + c0 + ch * 8); }
}
__device__ __forceinline__ void lru_chain(unsigned char* ws_, const float* const* in_, int l_, LAS unsigned char* lds, int tid, int bid, int G) {
    const MixCtx X = mk_mix(ws_, in_, l_); tid = launder_v(tid);
    const int lane = tid & 63, w = __builtin_amdgcn_readfirstlane(tid >> 6); const int l = X.l;
    LAS unsigned char* UB = lds + LR_UB; LAS float* A_ = (LAS float*)(lds + LR_A); LAS float* B_ = (LAS float*)(lds + LR_B);
    LAS unsigned char* WT = lds + LR_WT; LAS float* PRM = (LAS float*)(lds + LR_PRM); LAS float* SA = (LAS float*)(lds + LR_SA); LAS float* SB = (LAS float*)(lds + LR_SB); LAS unsigned char* GT = lds + LR_GT;
    LAS float* CAR = (LAS float*)(lds + LR_CAR);
    const int cg8 = tid & 7, tp = tid >> 3; const int j = lane & 15, kq = lane >> 4;
    for (int chain = bid; chain < BATCH * 6; chain += G) {
        const int b = chain / 6, h = chain % 6, c0 = h * 64;
        LruPre P; lru_load(X, b, h, 0, tid, P);
        f32x4 cwv[4][2], cbv[2];
#pragma unroll
        for (int e2 = 0; e2 < 2; ++e2) { cbv[e2] = *(const f32x4*)(gptr(X.in[8]) + l * LW + c0 + 8 * cg8 + 4 * e2);
#pragma unroll
            for (int k = 0; k < 4; ++k) cwv[k][e2] = *(const f32x4*)(gptr(X.in[7]) + (size_t)(l * 4 + k) * LW + c0 + 8 * cg8 + 4 * e2); }
        __syncthreads();
#pragma unroll
        for (int i = 0; i < 2; ++i) { const int idx = tid + 512 * i; const int row = idx >> 3, ch = idx & 7;
            *(LAS u32x4*)(WT + row * 144 + ch * 16) = *(const u32x4*)(X.WTG + (size_t)(l * 6 + h) * 8192 + idx * 8); }
        if (tid < 64) { PRM[tid] = gptr(X.in[10])[l * LW + c0 + tid]; PRM[64 + tid] = gptr(X.in[12])[l * LW + c0 + tid]; PRM[128 + tid] = log1pf(__expf(-gptr(X.in[13])[l * LW + c0 + tid])); CAR[tid] = 0.f; }
        LAS unsigned char* OT = lds + LR_A;
        for (int chunk = 0; chunk < 16; ++chunk) {
            const int t0 = chunk * 128;
            if (chunk > 0) {
#pragma unroll
                for (int i = 0; i < 2; ++i) { const int idx = tid + 512 * i; const int row = idx >> 3, ch = idx & 7;
                    *(u32x4*)(X.MIX + ((size_t)b * SEQ + t0 - 128 + row) * DM + AW + CW + c0 + ch * 8) = *(const LAS u32x4*)(OT + row * 144 + ch * 16); }
            }
#pragma unroll
            for (int i = 0; i < 2; ++i) { const int idx = tid + 512 * i; const int row = idx >> 3, ch = idx & 7; *(LAS u32x4*)(GT + row * 144 + ch * 16) = P.g[i]; }
            { f32x4 xv[5][2];
#pragma unroll
              for (int rr = 0; rr < 5; ++rr) { const u32x4 v = P.x[rr]; xv[rr][0] = (f32x4){bf_lo(v.x), bf_hi(v.x), bf_lo(v.y), bf_hi(v.y)}; xv[rr][1] = (f32x4){bf_lo(v.z), bf_hi(v.z), bf_lo(v.w), bf_hi(v.w)}; }
#pragma unroll
              for (int tk = 0; tk < 2; ++tk) { f32x4 u0 = cbv[0], u1 = cbv[1];
#pragma unroll
                  for (int k = 0; k < 4; ++k) { u0 += cwv[k][0] * xv[tk + k][0]; u1 += cwv[k][1] * xv[tk + k][1]; }
                  const int tok = 2 * tp + tk;
                  u32x4 pw; pw.x = cvt_pk_bf16(u0[0], u0[1]); pw.y = cvt_pk_bf16(u0[2], u0[3]); pw.z = cvt_pk_bf16(u1[0], u1[1]); pw.w = cvt_pk_bf16(u1[2], u1[3]);
                  *(LAS u32x4*)(UB + tok * 144 + cg8 * 16) = pw;
                  *(LAS f32x4*)(B_ + tok * 68 + cg8 * 8) = u0; *(LAS f32x4*)(B_ + tok * 68 + cg8 * 8 + 4) = u1; } }
            __syncthreads();
            if (chunk < 15) lru_load(X, b, h, chunk + 1, tid, P);
            { const int tok = 16 * w + j; bf16x8 bfr[2];
#pragma unroll
              for (int c = 0; c < 2; ++c) bfr[c] = *(const LAS bf16x8*)(UB + tok * 144 + kq * 16 + c * 64);
#pragma unroll
              for (int ot = 0; ot < 4; ++ot) { f32x4 da = (f32x4){0.f, 0.f, 0.f, 0.f}, dx = da;
#pragma unroll
                  for (int c = 0; c < 2; ++c) { const bf16x8 fa = *(const LAS bf16x8*)(WT + (16 * ot + j) * 144 + kq * 16 + c * 64), fx = *(const LAS bf16x8*)(WT + (64 + 16 * ot + j) * 144 + kq * 16 + c * 64);
                      da = __builtin_amdgcn_mfma_f32_16x16x32_bf16(fa, bfr[c], da, 0, 0, 0); dx = __builtin_amdgcn_mfma_f32_16x16x32_bf16(fx, bfr[c], dx, 0, 0, 0); }
                  const int ch = 16 * ot + 4 * kq;
                  const f32x4 ba4 = *(const LAS f32x4*)(PRM + ch), bx4 = *(const LAS f32x4*)(PRM + 64 + ch), sp4 = *(const LAS f32x4*)(PRM + 128 + ch);
                  const f32x4 u4 = *(const LAS f32x4*)(B_ + tok * 68 + ch); f32x4 a4, b4;
#pragma unroll
                  for (int e = 0; e < 4; ++e) { const float rg = sigmoidf_(da[e] + ba4[e]), ig = sigmoidf_(dx[e] + bx4[e]); const float la = -8.0f * rg * sp4[e];
                      const float av_ = __expf(la); a4[e] = av_; b4[e] = sqrtf(fmaxf(1.0f - av_ * av_, 0.f)) * ig * u4[e]; }
                  *(LAS f32x4*)(A_ + tok * 68 + ch) = a4; *(LAS f32x4*)(B_ + tok * 68 + ch) = b4; } }
            __syncthreads();
            float av[16], bv[16]; float hh = 0.f, aa = 1.f;
#pragma unroll
            for (int i = 0; i < 16; ++i) { av[i] = A_[(16 * w + i) * 68 + lane]; bv[i] = B_[(16 * w + i) * 68 + lane]; hh = av[i] * hh + bv[i]; aa *= av[i]; }
            SA[w * 64 + lane] = aa; SB[w * 64 + lane] = hh;
            __syncthreads();
            float hin = CAR[(chunk & 1) * 64 + lane];
            for (int sgi = 0; sgi < w; ++sgi) hin = SA[sgi * 64 + lane] * hin + SB[sgi * 64 + lane];
            hh = hin;
#pragma unroll
            for (int i = 0; i < 16; i += 2) { hh = av[i] * hh + bv[i]; const float h0 = hh; hh = av[i + 1] * hh + bv[i + 1]; const int tl = 16 * w + i;
                const float g0 = gelu_tanh(bf2f(*(const LAS bf16_t*)(GT + tl * 144 + lane * 2))), g1 = gelu_tanh(bf2f(*(const LAS bf16_t*)(GT + (tl + 1) * 144 + lane * 2)));
                const unsigned pk = cvt_pk_bf16(g0 * h0, g1 * hh);
                *(LAS bf16_t*)(OT + tl * 144 + lane * 2) = (bf16_t)(pk & 0xffffu); *(LAS bf16_t*)(OT + (tl + 1) * 144 + lane * 2) = (bf16_t)(pk >> 16); }
            if (w == 7) CAR[((chunk + 1) & 1) * 64 + lane] = hh;
            __syncthreads();
        }
#pragma unroll
        for (int i = 0; i < 2; ++i) { const int idx = tid + 512 * i; const int row = idx >> 3, ch = idx & 7;
            *(u32x4*)(X.MIX + ((size_t)b * SEQ + 15 * 128 + row) * DM + AW + CW + c0 + ch * 8) = *(const LAS u32x4*)(OT + row * 144 + ch * 16); }
    }
}

__device__ __forceinline__ void mixer_phase(const Ctx& C, int l) {
    lru_chain(C.ws, C.in, l, C.lds, C.tid, C.bid, C.G);
    int a_start, a_cnt, a_stride;
    if (C.G == 256) { if (C.bid >= 192) { a_start = (C.bid - 192) * 27; a_cnt = 27; } else { a_start = 64 * 27 + C.bid * 7; a_cnt = 7; } a_stride = 1; }
    else { a_start = C.bid; a_stride = C.G; a_cnt = (N_ATT - C.bid + C.G - 1) / C.G; }
    attn_loop(C.ws, C.in, l, C.lds, C.tid, a_start, a_cnt, a_stride);
    conv_loop(C.ws, C.in, l, C.lds, C.tid, C.bid, C.G);
}

__device__ __forceinline__ void alpha_phase(const Ctx& C) {
    const bf16_t* AO = (const bf16_t*)(C.ws + WS_AO); bf16_t* MIX = (bf16_t*)(C.ws + WS_MIX); const float* LSE = (const float*)(C.ws + WS_LSE);
    const int gw = C.bid * 8 + C.wave, NGW = C.G * 8;
    for (int tg = gw; tg < M / 4; tg += NGW) {
#pragma unroll
        for (int i = 0; i < 3; ++i) { const int L = C.lane + 64 * i; const size_t tok = (size_t)4 * tg + L / 48; const int ch = L % 48, h = ch >> 3, jj = h & 1, g = h >> 1;
            const float l0 = LSE[tok * 6 + jj], l1 = LSE[tok * 6 + 2 + jj], l2 = LSE[tok * 6 + 4 + jj];
            const float mx = fmaxf(l0, fmaxf(l1, l2)); const float e0 = __expf(l0 - mx), e1 = __expf(l1 - mx), e2 = __expf(l2 - mx);
            const float al = (g == 0 ? e0 : (g == 1 ? e1 : e2)) / (e0 + e1 + e2);
            const u32x4 v = *(const u32x4*)(AO + tok * AW + ch * 8); u32x4 o;
            o.x = pk2(bf_lo(v.x) * al, bf_hi(v.x) * al); o.y = pk2(bf_lo(v.y) * al, bf_hi(v.y) * al); o.z = pk2(bf_lo(v.z) * al, bf_hi(v.z) * al); o.w = pk2(bf_lo(v.w) * al, bf_hi(v.w) * al);
            *(u32x4*)(MIX + tok * DM + ch * 8) = o; }
    }
}

__device__ __forceinline__ void final_phase(const Ctx& C) {
    const u64* ssq = (const u64*)(C.ws + WS_SSQ) + 4 * (size_t)M; const float* g = gptr(C.in[18]);
    const int gw = C.bid * 8 + C.wave, NGW = C.G * 8;
    f32x4 gv[4];
#pragma unroll
    for (int j = 0; j < 2; ++j) { gv[2 * j] = *((const f32x4*)g + 2 * C.lane + 128 * j); gv[2 * j + 1] = *((const f32x4*)g + 2 * C.lane + 128 * j + 1); }
    const bf16_t* XB = (const bf16_t*)(C.ws + WS_XB);
    for (int m0 = gw * 4; m0 < M; m0 += NGW * 4) {
        u32x4 v[4][2]; float ri[4];
#pragma unroll
        for (int r = 0; r < 4; ++r) { ri[r] = rinv_from(__hip_atomic_load(ssq + m0 + r, __ATOMIC_RELAXED, __HIP_MEMORY_SCOPE_AGENT)); const u32x4* xi = (const u32x4*)(XB + (size_t)(m0 + r) * DM) + C.lane;
#pragma unroll
            for (int j = 0; j < 2; ++j) v[r][j] = xi[64 * j]; }
#pragma unroll
        for (int r = 0; r < 4; ++r) { f32x4* xr = (f32x4*)(C.out + (size_t)(m0 + r) * DM) + 2 * C.lane;
#pragma unroll
            for (int j = 0; j < 2; ++j) { const u32x4 q = v[r][j];
                xr[128 * j] = (f32x4){bf_lo(q.x), bf_hi(q.x), bf_lo(q.y), bf_hi(q.y)} * ri[r] * gv[2 * j];
                xr[128 * j + 1] = (f32x4){bf_lo(q.z), bf_hi(q.z), bf_lo(q.w), bf_hi(q.w)} * ri[r] * gv[2 * j + 1]; } }
    }
}

constexpr int N_PHASES = 14;
__global__ void __launch_bounds__(512, 2) fwd_kernel(Args args) {
    extern __shared__ __attribute__((aligned(16))) unsigned char lds_raw[];
#define IN(k) (true)
#define MKCTX Ctx C; C.in = args.in; C.out = (float*)launder((unsigned char*)args.out); C.ws = launder(args.ws); C.lds = (LAS unsigned char*)lds_raw; \
    C.tid = launder_v((int)threadIdx.x); C.lane = C.tid & 63; C.wave = __builtin_amdgcn_readfirstlane(C.tid >> 6); C.G = gridDim.x; C.bid = blockIdx.x;
    LAS unsigned char* const ldsp = (LAS unsigned char*)lds_raw; const int G_ = gridDim.x, bid_ = blockIdx.x;
#define SYNC(k) do { xcd_barrier(xbar); } while (0)
    { volatile LAS unsigned* misc = (volatile LAS unsigned*)(lds_raw + MISC_OFF); if (threadIdx.x < 16) misc[threadIdx.x] = 0u; __syncthreads(); }
    if (IN(0)) { MKCTX; prologue(C); }
    cg::this_grid().sync();
    XcdBarrier xbar = xcd_barrier_post((unsigned*)(args.ws + WS_BAR), (volatile LAS unsigned*)((LAS unsigned char*)lds_raw + MISC_OFF + 32));
    for (int l = 0; l < 2; ++l) {
        asm volatile("" : "+s"(l));
        const int pb = 1 + 6 * l;
        if (IN(pb)) {
            unsigned char* ws = launder(args.ws); unsigned char* wb = ws + WS_W + l * W_LAYER;
            pg8::Gemm g{(const bf16_t*)(ws + WS_XB), (const bf16_t*)(wb + WO_IN), M, INP, DM}; pg8::StaticOrder S; S.init(M, INP, G_, bid_);
            pg8::EpiRowScale<0> E{(bf16_t*)(ws + WS_Z), INC, (const u64*)(ws + WS_SSQ) + (size_t)(2 * l) * M, INC, ldsp + EPI_STG_OFF};
            pg8::gemm_phase<pg8::EpiRowScale<0>, pg8::StaticOrder, true, true>(ldsp, g, S, E);
        }
        SYNC(pb);
        if (IN(pb + 1)) { MKCTX; mixer_phase(C, l); }
        SYNC(pb + 1);
        if (IN(pb + 2)) { MKCTX; alpha_phase(C); }
        SYNC(pb + 2);
        if (IN(pb + 3)) {
            unsigned char* ws = launder(args.ws); unsigned char* wb = ws + WS_W + l * W_LAYER;
            pg8::Gemm g{(const bf16_t*)(ws + WS_MIX), (const bf16_t*)(wb + WO_OUT), M, DM, DM}; pg8::StaticOrder S; S.init(M, DM, G_, bid_);
            pg8::EpiResid E{(bf16_t*)(ws + WS_XB), (u64*)(ws + WS_SSQ) + (size_t)(2 * l + 1) * M};
            pg8::gemm_phase<pg8::EpiResid, pg8::StaticOrder, true, true>(ldsp, g, S, E);
        }
        SYNC(pb + 3);
        if (IN(pb + 4)) {
            unsigned char* ws = launder(args.ws); unsigned char* wb = ws + WS_W + l * W_LAYER;
            pg8::Gemm g{(const bf16_t*)(ws + WS_XB), (const bf16_t*)(wb + WO_UP), M, FF, DM}; pg8::StaticOrder S; S.init(M, FF, G_, bid_);
            pg8::EpiRowScale<1> E{(bf16_t*)(ws + WS_BIG), FF, (const u64*)(ws + WS_SSQ) + (size_t)(2 * l + 1) * M, FF, ldsp + EPI_STG_OFF};
            pg8::gemm_phase<pg8::EpiRowScale<1>, pg8::StaticOrder, true, true>(ldsp, g, S, E);
        }
        SYNC(pb + 4);
        if (IN(pb + 5)) {
            unsigned char* ws = launder(args.ws); unsigned char* wb = ws + WS_W + l * W_LAYER;
            pg8::Gemm g{(const bf16_t*)(ws + WS_BIG), (const bf16_t*)(wb + WO_DN), M, DM, FF}; pg8::StaticOrder S; S.init(M, DM, G_, bid_);
            pg8::EpiResid E{(bf16_t*)(ws + WS_XB), (u64*)(ws + WS_SSQ) + (size_t)(2 * l + 2) * M};
            pg8::gemm_phase<pg8::EpiResid, pg8::StaticOrder, true, true>(ldsp, g, S, E);
        }
        SYNC(pb + 5);
    }
    if (IN(13)) { MKCTX; final_phase(C); }
#undef IN
#undef SYNC
#undef MKCTX
}

extern "C" void kernel_launch(void* const* d_in, const int* in_sizes, int n_in, void* d_out, int out_size, void* d_ws, size_t ws_size, hipStream_t stream) {
    static int grid = 0;
    if (grid == 0) {
        if (n_in != 19 || in_sizes[0] != M * DM || out_size != M * DM || ws_size < WS_END) { fprintf(stderr, "kernel_launch: unexpected shapes (n_in %d, in0 %d, out %d, ws %zu)\n", n_in, n_in > 0 ? in_sizes[0] : -1, out_size, ws_size); grid = -1; return; }
        int dev = 0, cus = 0, per_cu = 0;
        if (hipGetDevice(&dev) != hipSuccess || hipDeviceGetAttribute(&cus, hipDeviceAttributeMultiprocessorCount, dev) != hipSuccess) { grid = -1; return; }
        if (hipFuncSetAttribute((const void*)fwd_kernel, hipFuncAttributeMaxDynamicSharedMemorySize, LDS_BYTES) != hipSuccess) { fprintf(stderr, "kernel_launch: hipFuncSetAttribute failed\n"); grid = -1; return; }
        if (hipOccupancyMaxActiveBlocksPerMultiprocessor(&per_cu, (const void*)fwd_kernel, 512, LDS_BYTES) != hipSuccess || per_cu < 1) { fprintf(stderr, "kernel_launch: occupancy query says %d\n", per_cu); per_cu = 1; }
        (void)hipGetLastError();
        grid = cus * per_cu;
    }
    if (grid < 0) return;
    Args a{};
    for (int i = 0; i < 19; ++i) a.in[i] = (const float*)d_in[i];
    a.out = (float*)d_out; a.ws = (unsigned char*)d_ws;
#if ONE_LAUNCH
    a.ph_lo = 0; a.ph_hi = N_PHASES;
    void* kargs[] = {&a};
    hipError_t e = hipLaunchCooperativeKernel((const void*)fwd_kernel, dim3(grid), dim3(512), kargs, LDS_BYTES, stream);
    if (e != hipSuccess) fprintf(stderr, "cooperative launch failed: %s (grid %d)\n", hipGetErrorString(e), grid);
#else
    for (int p = 0; p < N_PHASES; ++p) { a.ph_lo = p; a.ph_hi = p + 1; hipLaunchKernelGGL(fwd_kernel, dim3(grid), dim3(512), LDS_BYTES, stream, a); }
#endif
}
```

```cpp
#include <hip/hip_runtime.h>
#include <hip/hip_cooperative_groups.h>
#include <cstdio>
#include <cstdint>
namespace cg = cooperative_groups;

#ifndef ONE_LAUNCH
#define ONE_LAUNCH 1
#endif

#define LAS __attribute__((address_space(3)))
typedef unsigned short bf16_t;
typedef short bf16x8 __attribute__((ext_vector_type(8)));
typedef float f32x4 __attribute__((ext_vector_type(4)));
typedef float f32x2 __attribute__((ext_vector_type(2)));
typedef unsigned u32x4 __attribute__((ext_vector_type(4)));
typedef unsigned u32x2 __attribute__((ext_vector_type(2)));
typedef short v4i16_t __attribute__((ext_vector_type(4)));
typedef unsigned long long u64;

constexpr int DM = 1024, BATCH = 32, SEQ = 2048, M = BATCH * SEQ;
constexpr int HD = 64, AW = 384, CW = 256, LW = 384, INC = 2432, INP = 2560, FF = 4096;
constexpr int Q0 = 0, K0 = 384, V0 = 768, CA0 = 1152, CG0 = 1408, LG0 = 1664, LX0 = 2048;
constexpr float RMS_EPS = 1e-6f, LN_EPS = 1e-5f;
constexpr float LOG2E = 1.4426950408889634f, LN2 = 0.6931471805599453f;

constexpr size_t MiB = 1u << 20;
constexpr size_t WS_CTR = 0, WS_BAR = 65536;
constexpr size_t WS_CTR_UNUSED = 0;
constexpr size_t WS_W = 2 * MiB, W_LAYER = 23 * MiB;
constexpr size_t WO_IN = 0, WO_OUT = 5 * MiB, WO_UP = 7 * MiB, WO_DN = 15 * MiB;
constexpr size_t WS_SSQ = 48 * MiB;
constexpr size_t WS_LSE = 51 * MiB;
constexpr size_t WS_XB = 53 * MiB;
constexpr size_t WS_BIG = 181 * MiB;
constexpr size_t WS_Z = WS_BIG, WS_MIX = WS_BIG + 304 * MiB, WS_AO = WS_BIG + 432 * MiB;
constexpr size_t WS_Y2 = WS_BIG + 480 * MiB, WS_SUM = WS_BIG + 528 * MiB;
constexpr size_t WS_WTG = 1 * MiB;
constexpr size_t WS_END = WS_BIG + 530 * MiB;
constexpr int N_LRUC = 6 * BATCH * 16, N_ATT = BATCH * 96;

constexpr int LDS_BYTES = 151552;
constexpr int EPI_STG_OFF = 131072 + 1024, EPI_STG_SLICE = 2304;
constexpr int MISC_OFF = 131072;

__device__ __forceinline__ float bf_lo(unsigned w) { return __uint_as_float(w << 16); }
__device__ __forceinline__ float bf_hi(unsigned w) { return __uint_as_float(w & 0xffff0000u); }
__device__ __forceinline__ float bf2f(bf16_t b) { return __uint_as_float((unsigned)b << 16); }
__device__ __forceinline__ unsigned f2bf(float f) { unsigned u = __float_as_uint(f); return (u + 0x7fffu + ((u >> 16) & 1u)) >> 16; }
__device__ __forceinline__ unsigned pk2(float lo, float hi) { return f2bf(lo) | (f2bf(hi) << 16); }
__device__ __forceinline__ unsigned cvt_pk_bf16(float lo, float hi) { unsigned r; asm volatile("v_cvt_pk_bf16_f32 %0, %1, %2" : "=v"(r) : "v"(lo), "v"(hi)); return r; }
__device__ __forceinline__ float sigmoidf_(float x) { return __builtin_amdgcn_rcpf(1.f + __expf(-x)); }
__device__ __forceinline__ float wave_sum(float v) {
#pragma unroll
    for (int o = 1; o < 64; o <<= 1) v += __shfl_xor(v, o);
    return v;
}
__device__ __forceinline__ float rinv_from(u64 v) { return rsqrtf((float)v * (1.0f / 16777216.0f) * (1.0f / 1024.0f) + RMS_EPS); }

namespace pg8 {
constexpr int BM = 256, BK = 64, HALF = 128, HTB = HALF * BK * 2, STAGE_BYTES = 8 * HTB, NXCD = 8, WGM = 8;
__host__ __device__ __forceinline__ int lds_byte(int r, int c) { const int st = (r >> 4) * 2 + (c >> 5), rr = r & 15, cc = c & 31, ob = rr * 64 + cc * 2; return st * 1024 + (ob ^ (((ob >> 9) & 1) << 5)); }
__host__ __device__ __forceinline__ void stage_rc(int b, int& R, int& C) { const int st = b / 1024, sb = b % 1024, swz = sb ^ (((sb >> 9) & 1) << 5); R = (st >> 1) * 16 + swz / 64; C = (st & 1) * 32 + (swz % 64) / 2; }
__host__ __device__ __forceinline__ int perm32(int rho) { const int n = rho >> 4, i = rho & 15; return 8 * (i >> 2) + 4 * n + (i & 3); }

struct Unit { int pm, pn; };
struct Gemm { const bf16_t* A; const bf16_t* Bt; int M, N, K; };

struct StaticOrder {
    int nM, nN, nwg, G, c;
    __host__ __device__ void init(int M_, int N_, int G_, int c_) { nM = M_ / BM; nN = N_ / BM; nwg = nM * nN; G = G_; c = c_; }
    __host__ __device__ bool next(int i, Unit& u) const {
        const long L = (long)i * G + c; if (L >= nwg) return false;
        int wgid = (int)L; { const int q = nwg / NXCD, r = nwg % NXCD, xcd = wgid % NXCD, off = wgid / NXCD; wgid = (xcd < r ? xcd * (q + 1) : r * (q + 1) + (xcd - r) * q) + off; }
        const int nig = WGM * nN, gid = wgid / nig, fm = gid * WGM, gsz = (nM - fm) < WGM ? (nM - fm) : WGM;
        u.pm = fm + ((wgid % nig) % gsz); u.pn = (wgid % nig) / gsz; return true;
    }
    __device__ __forceinline__ void a_ready(const Unit&) const {}
    __device__ __forceinline__ void done(const Unit&) const {}
};

template <int ACT> struct EpiRowScale {
    static constexpr bool PERM = true, AFTER_DRAIN = false;
    bf16_t* O; int ldc; const u64* ssq; int nvalid; LAS unsigned char* stg;
    __device__ __forceinline__ void operator()(const f32x4 (&acc)[2][2][4][2], const Unit& u, int wr, int wc, int fr, int fq) const {
        const int ln = fr + 16 * fq; const int colw = u.pn * BM + 64 * wc;
        if (colw >= nvalid) return;
        float rl[2];
#pragma unroll
        for (int ai = 0; ai < 2; ++ai) rl[ai] = rinv_from(ssq[u.pm * BM + ai * HALF + wr * 64 + ln]);
        LAS unsigned char* sl = stg + (wr * 4 + wc) * EPI_STG_SLICE;
        const int rr = ln >> 3, cc = ln & 7;
#pragma unroll
        for (int ai = 0; ai < 2; ++ai)
#pragma unroll
            for (int m = 0; m < 4; ++m) {
                const float sc = __shfl(rl[ai], 16 * m + fr);
#pragma unroll
                for (int bj = 0; bj < 2; ++bj) {
                    f32x4 v0 = acc[ai][bj][m][0] * sc, v1 = acc[ai][bj][m][1] * sc;
                    if (ACT == 1) {
#pragma unroll
                        for (int e = 0; e < 4; ++e) { float a = fmaxf(v0[e], 0.f), b = fmaxf(v1[e], 0.f); v0[e] = a * a; v1[e] = b * b; }
                    }
                    u32x4 w; w.x = cvt_pk_bf16(v0[0], v0[1]); w.y = cvt_pk_bf16(v0[2], v0[3]); w.z = cvt_pk_bf16(v1[0], v1[1]); w.w = cvt_pk_bf16(v1[2], v1[3]);
                    *(LAS u32x4*)(sl + fr * 144 + bj * 64 + fq * 16) = w;
                }
                const int rowb = u.pm * BM + ai * HALF + wr * 64 + m * 16;
#pragma unroll
                for (int i = 0; i < 2; ++i) { const int r = rr + 8 * i; const u32x4 q = *(const LAS u32x4*)(sl + r * 144 + cc * 16);
                    __builtin_nontemporal_store(q, (u32x4*)(O + (size_t)(rowb + r) * ldc + colw + cc * 8)); }
            }
    }
};
struct EpiResid {
    static constexpr bool PERM = true, AFTER_DRAIN = false;
    bf16_t* xb; u64* ssq; LAS unsigned char* stg;
    __device__ __forceinline__ void operator()(const f32x4 (&acc)[2][2][4][2], const Unit& u, int wr, int wc, int fr, int fq) const {
        const int ln = fr + 16 * fq, rr = ln >> 3, cc = ln & 7; const int colw = u.pn * BM + 64 * wc;
        LAS unsigned char* sl = stg + (wr * 4 + wc) * EPI_STG_SLICE;
#pragma unroll
        for (int ai = 0; ai < 2; ++ai) {
            float qs[4];
#pragma unroll
            for (int mh = 0; mh < 2; ++mh) {
            u32x4 bs[4][2];
#pragma unroll
            for (int m = 2 * mh; m < 2 * mh + 2; ++m) { const int rowb = u.pm * BM + ai * HALF + wr * 64 + m * 16;
#pragma unroll
                for (int i = 0; i < 2; ++i) bs[m][i] = *(const u32x4*)(xb + (size_t)(rowb + rr + 8 * i) * DM + colw + cc * 8); }
#pragma unroll
            for (int m = 2 * mh; m < 2 * mh + 2; ++m) {
                const int rowb = u.pm * BM + ai * HALF + wr * 64 + m * 16; float q = 0.f;
#pragma unroll
                for (int i = 0; i < 2; ++i) *(LAS u32x4*)(sl + (rr + 8 * i) * 144 + cc * 16) = bs[m][i];
#pragma unroll
                for (int bj = 0; bj < 2; ++bj) {
                    const u32x4 b4 = *(const LAS u32x4*)(sl + fr * 144 + bj * 64 + fq * 16);
                    const f32x4 a0 = acc[ai][bj][m][0], a1 = acc[ai][bj][m][1];
                    const float o0 = bf_lo(b4.x) + a0[0], o1 = bf_hi(b4.x) + a0[1], o2 = bf_lo(b4.y) + a0[2], o3 = bf_hi(b4.y) + a0[3];
                    const float o4 = bf_lo(b4.z) + a1[0], o5 = bf_hi(b4.z) + a1[1], o6 = bf_lo(b4.w) + a1[2], o7 = bf_hi(b4.w) + a1[3];
                    q += ((o0 * o0 + o1 * o1) + (o2 * o2 + o3 * o3)) + ((o4 * o4 + o5 * o5) + (o6 * o6 + o7 * o7));
                    u32x4 w; w.x = cvt_pk_bf16(o0, o1); w.y = cvt_pk_bf16(o2, o3); w.z = cvt_pk_bf16(o4, o5); w.w = cvt_pk_bf16(o6, o7);
                    *(LAS u32x4*)(sl + fr * 144 + bj * 64 + fq * 16) = w;
                }
#pragma unroll
                for (int i = 0; i < 2; ++i) { const u32x4 qv = *(const LAS u32x4*)(sl + (rr + 8 * i) * 144 + cc * 16);
                    *(u32x4*)(xb + (size_t)(rowb + rr + 8 * i) * DM + colw + cc * 8) = qv; }
                q += __shfl_xor(q, 16); q += __shfl_xor(q, 32); qs[m] = q;
            }
            asm volatile("" ::: "memory");
            }
            { const float mine = fq == 0 ? qs[0] : (fq == 1 ? qs[1] : (fq == 2 ? qs[2] : qs[3]));
              __hip_atomic_fetch_add(ssq + (u.pm * BM + ai * HALF + wr * 64 + 16 * fq + fr), (u64)(mine * 16777216.0f), __ATOMIC_RELAXED, __HIP_MEMORY_SCOPE_AGENT); }
            asm volatile("" ::: "memory");
        }
    }
};

template <class Epi, class Sched, bool ALIGN_EPI = false, bool SP2 = false>
__device__ __forceinline__ void gemm_phase(LAS unsigned char* lds, const Gemm g, const Sched& S, const Epi& E) {
    int tid_ = (int)threadIdx.x; asm volatile("" : "+v"(tid_));
    const int tid = tid_, wid = __builtin_amdgcn_readfirstlane(tid >> 6), lane = tid & 63, wr = wid >> 2, wc = wid & 3, fr = lane & 15, fq = lane >> 4;
    const int K = g.K, nt = K / BK;
    unsigned voffA[2], voffB[2];
#pragma unroll
    for (int i = 0; i < 2; ++i) { int R, C; stage_rc(tid * 16 + i * 8192, R, C); const int Rb = Epi::PERM ? ((R & ~31) + perm32(R & 31)) : R;
        voffA[i] = (unsigned)(R * K + C) * 2u; voffB[i] = (unsigned)(Rb * K + C) * 2u; }
    const size_t kstep = (size_t)(BK * 2);
    const size_t hstep = (size_t)HALF * K * 2;
    const size_t tstep = 2 * hstep;
    const unsigned ldsw = (unsigned)wid * 1024u;
    const int aoff = lds_byte(wr * 64 + fr, fq * 8), boff = lds_byte(wc * 32 + fr, fq * 8);
#define PG8_SA(b, h) (((b) * 2 + (h)) * HTB)
#define PG8_SB(b, h) ((4 + (b) * 2 + (h)) * HTB)
#define PG8_STAGE(bufoff, gbase, voff) do { _Pragma("unroll") for (int _i = 0; _i < 2; ++_i) \
        __builtin_amdgcn_global_load_lds((const unsigned*)((const char*)(gbase) + (voff)[_i]), (LAS unsigned*)(lds + (bufoff) + ldsw + _i * 8192), 16, 0, 0); } while (0)
#define PG8_LDA(dst, b, h) do { _Pragma("unroll") for (int m = 0; m < 4; ++m) _Pragma("unroll") for (int k = 0; k < 2; ++k) dst[m][k] = *(const LAS bf16x8*)(lds + PG8_SA(b, h) + aoff + m * 2048 + k * 1024); } while (0)
#define PG8_LDB(dst, b, h) do { _Pragma("unroll") for (int n = 0; n < 2; ++n) _Pragma("unroll") for (int k = 0; k < 2; ++k) dst[n][k] = *(const LAS bf16x8*)(lds + PG8_SB(b, h) + boff + n * 2048 + k * 1024); } while (0)
#define PG8_MMA(ai, bj, At, Bt) do { __builtin_amdgcn_s_setprio(1); _Pragma("unroll") for (int m = 0; m < 4; ++m) _Pragma("unroll") for (int n = 0; n < 2; ++n) _Pragma("unroll") for (int k = 0; k < 2; ++k) \
        acc[ai][bj][m][n] = __builtin_amdgcn_mfma_f32_16x16x32_bf16(Bt[n][k], At[m][k], acc[ai][bj][m][n], 0, 0, 0); __builtin_amdgcn_s_setprio(0); } while (0)
#define PG8_WAIT_V(n) asm volatile("s_waitcnt vmcnt(" #n ")" ::: "memory")
#define PG8_WAIT_L(n) asm volatile("s_waitcnt lgkmcnt(" #n ")" ::: "memory")
#define PG8_BAR __builtin_amdgcn_s_barrier()
#define PG8_SCHED __builtin_amdgcn_sched_barrier(0)
    Unit cur, nxt; int ui = 0;
    if (!S.next(0, cur)) return;
    f32x4 acc[2][2][4][2];
#pragma unroll
    for (int a = 0; a < 2; ++a)
#pragma unroll
        for (int b = 0; b < 2; ++b)
#pragma unroll
            for (int m = 0; m < 4; ++m)
#pragma unroll
                for (int n = 0; n < 2; ++n) acc[a][b][m][n] = (f32x4){0.f, 0.f, 0.f, 0.f};
    bf16x8 At[4][2], B0[2][2], B1[2][2];
    const char* cA = (const char*)g.A + (size_t)cur.pm * tstep; const char* cB = (const char*)g.Bt + (size_t)cur.pn * tstep;
    S.a_ready(cur);
    if constexpr (SP2) {
        PG8_STAGE(PG8_SB(0, 0), cB, voffB); PG8_STAGE(PG8_SB(0, 1), cB + hstep, voffB); PG8_STAGE(PG8_SA(0, 0), cA, voffA); PG8_STAGE(PG8_SA(0, 1), cA + hstep, voffA);
        if (wr == 1) PG8_BAR;
        PG8_WAIT_V(2); PG8_BAR;
        PG8_STAGE(PG8_SB(1, 0), cB + kstep, voffB); PG8_STAGE(PG8_SA(1, 0), cA + kstep, voffA); PG8_STAGE(PG8_SB(1, 1), cB + hstep + kstep, voffB);
        PG8_WAIT_V(6); PG8_BAR;
    } else {
        PG8_STAGE(PG8_SB(0, 0), cB, voffB); PG8_STAGE(PG8_SA(0, 0), cA, voffA); PG8_STAGE(PG8_SB(0, 1), cB + hstep, voffB); PG8_STAGE(PG8_SA(0, 1), cA + hstep, voffA);
        if (wr == 1) PG8_BAR;
        PG8_WAIT_V(4); PG8_BAR;
        PG8_STAGE(PG8_SB(1, 0), cB + kstep, voffB); PG8_STAGE(PG8_SA(1, 0), cA + kstep, voffA); PG8_STAGE(PG8_SB(1, 1), cB + hstep + kstep, voffB);
        PG8_WAIT_V(6); PG8_BAR;
    }
    for (;;) {
        const bool has_next = S.next(ui + 1, nxt);
        const char* nA = has_next ? (const char*)g.A + (size_t)nxt.pm * tstep : cA; const char* nB = has_next ? (const char*)g.Bt + (size_t)nxt.pn * tstep : cB;
        for (int t = 0; t < nt; t += 2) {
            const bool last = (t == nt - 2);
            const char* a1 = cA + (size_t)(t + 1) * kstep;
            const char* a2 = last ? nA : cA + (size_t)(t + 2) * kstep; const char* b2 = last ? nB : cB + (size_t)(t + 2) * kstep;
            const char* a3 = a2 + kstep; const char* b3 = b2 + kstep;
            if (last && has_next) S.a_ready(nxt);
            if constexpr (SP2) {
            PG8_LDB(B0, 0, 0); PG8_LDB(B1, 0, 1); PG8_SCHED; PG8_LDA(At, 0, 0); PG8_STAGE(PG8_SA(1, 1), a1 + hstep, voffA);
            PG8_WAIT_V(8); PG8_WAIT_L(0); PG8_BAR; PG8_MMA(0, 0, At, B0); PG8_MMA(0, 1, At, B1); PG8_BAR; PG8_SCHED;
            PG8_LDA(At, 0, 1); PG8_STAGE(PG8_SB(0, 0), b2, voffB); PG8_STAGE(PG8_SB(0, 1), b2 + hstep, voffB); PG8_STAGE(PG8_SA(0, 0), a2, voffA);
            PG8_WAIT_V(8); PG8_WAIT_L(0); PG8_BAR; PG8_MMA(1, 0, At, B0); PG8_MMA(1, 1, At, B1); PG8_BAR; PG8_SCHED;
            PG8_LDB(B0, 1, 0); PG8_LDB(B1, 1, 1); PG8_SCHED; PG8_LDA(At, 1, 0); PG8_STAGE(PG8_SA(0, 1), a2 + hstep, voffA);
            PG8_WAIT_V(8); PG8_WAIT_L(0); PG8_BAR; PG8_MMA(0, 0, At, B0); PG8_MMA(0, 1, At, B1); PG8_BAR; PG8_SCHED;
            PG8_LDA(At, 1, 1); PG8_STAGE(PG8_SB(1, 0), b3, voffB); PG8_STAGE(PG8_SB(1, 1), b3 + hstep, voffB); PG8_STAGE(PG8_SA(1, 0), a3, voffA);
            PG8_WAIT_V(8); PG8_WAIT_L(0); PG8_BAR; PG8_MMA(1, 0, At, B0); PG8_MMA(1, 1, At, B1); PG8_BAR; PG8_SCHED;
            } else {
            PG8_LDB(B0, 0, 0); PG8_SCHED; PG8_LDA(At, 0, 0); PG8_STAGE(PG8_SA(1, 1), a1 + hstep, voffA);
            PG8_WAIT_L(8); PG8_BAR; PG8_WAIT_L(0); PG8_MMA(0, 0, At, B0); PG8_BAR; PG8_SCHED;
            PG8_LDB(B1, 0, 1); PG8_STAGE(PG8_SB(0, 0), b2, voffB);
            PG8_BAR; PG8_WAIT_L(0); PG8_MMA(0, 1, At, B1); PG8_BAR;
            PG8_LDA(At, 0, 1); PG8_STAGE(PG8_SA(0, 0), a2, voffA);
            PG8_BAR; PG8_WAIT_L(0); PG8_MMA(1, 0, At, B0); PG8_BAR; PG8_SCHED;
            PG8_STAGE(PG8_SB(0, 1), b2 + hstep, voffB);
            PG8_WAIT_V(6); PG8_BAR; PG8_MMA(1, 1, At, B1); PG8_BAR;
            PG8_LDB(B0, 1, 0); PG8_SCHED; PG8_LDA(At, 1, 0); PG8_STAGE(PG8_SA(0, 1), a2 + hstep, voffA);
            PG8_WAIT_L(8); PG8_BAR; PG8_WAIT_L(0); PG8_MMA(0, 0, At, B0); PG8_BAR; PG8_SCHED;
            PG8_LDB(B1, 1, 1); PG8_STAGE(PG8_SB(1, 0), b3, voffB);
            PG8_BAR; PG8_WAIT_L(0); PG8_MMA(0, 1, At, B1); PG8_BAR;
            PG8_LDA(At, 1, 1); PG8_STAGE(PG8_SA(1, 0), a3, voffA);
            PG8_BAR; PG8_WAIT_L(0); PG8_MMA(1, 0, At, B0); PG8_BAR; PG8_SCHED;
            PG8_STAGE(PG8_SB(1, 1), b3 + hstep, voffB);
            PG8_WAIT_V(6); PG8_BAR; PG8_MMA(1, 1, At, B1); PG8_BAR;
            }
        }
        if constexpr (ALIGN_EPI) { if (wr == 0) PG8_BAR; }
        if constexpr (!Epi::AFTER_DRAIN) { E(acc, cur, wr, wc, fr, fq); S.done(cur); }
        if (!has_next) break;
#pragma unroll
        for (int a = 0; a < 2; ++a)
#pragma unroll
            for (int b = 0; b < 2; ++b)
#pragma unroll
                for (int m = 0; m < 4; ++m)
#pragma unroll
                    for (int n = 0; n < 2; ++n) acc[a][b][m][n] = (f32x4){0.f, 0.f, 0.f, 0.f};
        cur = nxt; cA = nA; cB = nB; ++ui;
        if constexpr (ALIGN_EPI) { if (wr == 1) PG8_BAR; }
    }
    PG8_WAIT_V(0);
    if constexpr (!ALIGN_EPI) { if (wr == 0) PG8_BAR; }
    PG8_BAR;
#undef PG8_SA
#undef PG8_SB
#undef PG8_STAGE
#undef PG8_LDA
#undef PG8_LDB
#undef PG8_MMA
#undef PG8_WAIT_V
#undef PG8_WAIT_L
#undef PG8_BAR
#undef PG8_SCHED
}
}

typedef __attribute__((address_space(1))) unsigned char gchar_t;
__device__ __forceinline__ unsigned char* launder(unsigned char* p) { size_t z = 0; asm volatile("" : "+s"(z)); return p + z; }
__device__ __forceinline__ const float* gptr(const float* p) { return (const float*)(const __attribute__((address_space(1))) float*)p; }
__device__ __forceinline__ int launder_v(int x) { asm volatile("" : "+v"(x)); return x; }

#define XB_TMO      128
#define XB_XCNT(j)  (256  + 64 * (j))
#define XB_XSUB(j)  (1280 + 64 * (j))
#define XB_XGEN(j)  (2304 + 64 * (j))
#define XB_TOP      3328
#define XB_TOPGEN   3392
#define XCD_BAR_WORDS 3456
#define XB_SPIN_CAP (1u << 18)
__device__ __forceinline__ unsigned xb_ld(unsigned* p)              { return __hip_atomic_load(p, __ATOMIC_RELAXED, __HIP_MEMORY_SCOPE_AGENT); }
__device__ __forceinline__ unsigned xb_add(unsigned* p, unsigned v) { return __hip_atomic_fetch_add(p, v, __ATOMIC_RELAXED, __HIP_MEMORY_SCOPE_AGENT); }
__device__ __forceinline__ unsigned xb_xcc_id() { return (unsigned)__builtin_amdgcn_s_getreg((3 << 11) | 20) & 0xFu; }
#define XB_SPIN(cond, bar) do { unsigned _sp = 0; while (cond) { __builtin_amdgcn_s_sleep(1); \
    if ((++_sp & 255u) == 0u) { if (xb_ld(&(bar)[XB_TMO])) break; if (_sp > XB_SPIN_CAP) { atomicAdd(&(bar)[XB_TMO], 1u); break; } } } } while (0)
struct XcdBarrier { unsigned* bar; unsigned x; volatile LAS unsigned* st; };
__device__ __forceinline__ XcdBarrier xcd_barrier_post(unsigned* bar, volatile LAS unsigned* st) {
    XcdBarrier b; b.bar = bar; b.x = xb_xcc_id(); b.st = st;
    if (threadIdx.x == 0) (void)xb_add(&bar[XB_XCNT(b.x)], 1u);
    return b;
}
__device__ __forceinline__ void xcd_barrier_complete(unsigned* bar, unsigned x, unsigned& nloc, unsigned& nx) {
    const unsigned G = gridDim.x * gridDim.y * gridDim.z;
    unsigned sum, cnt, mine, sp = 0u;
    for (;;) {
        sum = 0u; cnt = 0u; mine = 0u;
#pragma unroll
        for (unsigned j = 0; j < 16; ++j) { const unsigned c = xb_ld(&bar[XB_XCNT(j)]); sum += c; cnt += (c > 0u) ? 1u : 0u; mine = (j == x) ? c : mine; }
        if (sum == G) break;
        __builtin_amdgcn_s_sleep(1);
        if ((++sp & 255u) == 0u) { if (xb_ld(&bar[XB_TMO])) break; if (sp > XB_SPIN_CAP) { atomicAdd(&bar[XB_TMO], 1u); break; } }
    }
    nloc = mine > 0u ? mine : 1u; nx = cnt > 0u ? cnt : 1u;
}
__device__ __forceinline__ void xcd_barrier(const XcdBarrier& b) {
    asm volatile("s_waitcnt vmcnt(0)" ::: "memory");
    __syncthreads();
    if (threadIdx.x == 0) {
        unsigned* bar = b.bar;
        __builtin_amdgcn_s_waitcnt(0);
        unsigned nloc = b.st[0], nx = b.st[1];
        if (nloc == 0u) { xcd_barrier_complete(bar, b.x, nloc, nx); b.st[0] = nloc; b.st[1] = nx; }
        const unsigned old = xb_add(&bar[XB_XSUB(b.x)], 1u);
        const unsigned gen = old / nloc;
        if (old + 1u == (gen + 1u) * nloc) {
            __builtin_amdgcn_fence(__ATOMIC_RELEASE, "agent");
            asm volatile("s_waitcnt vmcnt(0)" ::: "memory");
            const unsigned og = xb_add(&bar[XB_TOP], 1u);
            const unsigned tg = og / nx;
            if (og + 1u == (tg + 1u) * nx) xb_add(&bar[XB_TOPGEN], 1u);
            else XB_SPIN(xb_ld(&bar[XB_TOPGEN]) == tg, bar);
            __builtin_amdgcn_fence(__ATOMIC_ACQUIRE, "agent");
            xb_add(&bar[XB_XGEN(b.x)], 1u);
            asm volatile("s_waitcnt vmcnt(0)" ::: "memory");
        } else {
            XB_SPIN(xb_ld(&bar[XB_XGEN(b.x)]) == gen, bar);
            __builtin_amdgcn_fence(__ATOMIC_ACQUIRE, "agent");
            asm volatile("s_waitcnt vmcnt(0)" ::: "memory");
        }
    }
    __syncthreads();
}
struct Args { const float* in[19]; float* out; unsigned char* ws; int ph_lo, ph_hi; };

struct Ctx {
    const float* const* in; float* out; unsigned char* ws;
    LAS unsigned char* lds; int tid, lane, wave, G, bid;
};

__host__ __device__ __forceinline__ int wrow(int n) { return (n & ~255) | (((n >> 5) & 1) << 7) | (((n >> 6) & 3) << 5) | (n & 31); }
__device__ __forceinline__ void tr_item(const float* W, int K, int N, bf16_t* WT, const float* gs, LAS float* scr, int item, int lane) {
    const int nblk = N / 32, kb = item / nblk, nb = item % nblk, k0 = 64 * kb, n0 = 32 * nb;
    const int c4 = (lane & 7) * 4;
#pragma unroll
    for (int i = 0; i < 8; ++i) { const int kk = 8 * i + (lane >> 3); const float s = gs ? gs[k0 + kk] : 1.f; const f32x4 v = *(const f32x4*)(W + (size_t)(k0 + kk) * N + n0 + c4) * s;
        LAS float* d = scr + kk * 33 + c4; d[0] = v[0]; d[1] = v[1]; d[2] = v[2]; d[3] = v[3]; }
    asm volatile("s_waitcnt lgkmcnt(0)" ::: "memory");
    const int c = lane & 7;
#pragma unroll
    for (int j = 0; j < 4; ++j) { const int n = (lane >> 3) + 8 * j; const LAS float* s = scr + (8 * c) * 33 + n;
        u32x4 o; o.x = pk2(s[0 * 33], s[1 * 33]); o.y = pk2(s[2 * 33], s[3 * 33]); o.z = pk2(s[4 * 33], s[5 * 33]); o.w = pk2(s[6 * 33], s[7 * 33]);
        *(u32x4*)(WT + (size_t)wrow(n0 + n) * K + k0 + 8 * c) = o; }
    asm volatile("s_waitcnt lgkmcnt(0)" ::: "memory");
}

__device__ __forceinline__ void prologue(const Ctx& C) {
    const int gw = C.bid * 8 + C.wave, NGW = C.G * 8; const int gt = C.bid * 512 + C.tid, NGT = C.G * 512;
    { u64* s = (u64*)(C.ws + WS_SSQ) + M; for (int i = gt; i < 4 * M; i += NGT) s[i] = 0ull;
      unsigned* ctr = (unsigned*)(C.ws + WS_CTR); if (gt < 64) ctr[gt] = 0u;
      unsigned* barw = (unsigned*)(C.ws + WS_BAR); if (gt < 3456) barw[gt] = 0u;
      for (int l = 0; l < 2; ++l) { bf16_t* wt = (bf16_t*)(C.ws + WS_W + l * W_LAYER + WO_IN); for (int i = gt; i < (INP - INC) * DM / 8; i += NGT) { const int n = INC + i / (DM / 8), ch = i % (DM / 8); *(u32x4*)(wt + (size_t)wrow(n) * DM + ch * 8) = (u32x4){0u, 0u, 0u, 0u}; } } }
    { bf16_t* wtg = (bf16_t*)(C.ws + WS_WTG);
      for (int i = gt; i < 2 * 6 * 2 * 4096; i += NGT) { const int o = i & 63, k = (i >> 6) & 63, mat = (i >> 12) & 1, lh = i >> 13;
          const float v = (mat ? gptr(C.in[11]) : gptr(C.in[9]))[(size_t)lh * 4096 + k * 64 + o]; wtg[((size_t)(lh * 2 + mat) * 64 + o) * 64 + k] = (bf16_t)f2bf(v); } }
    LAS float* scr = (LAS float*)(C.lds + C.wave * 16384);
    constexpr int I_IN = (DM / 64) * (INC / 32), I_OUT = (DM / 64) * (DM / 32), I_UP = (DM / 64) * (FF / 32), I_DN = (FF / 64) * (DM / 32), I_L = I_IN + I_OUT + I_UP + I_DN;
    for (int it = gw; it < 2 * I_L; it += NGW) {
        const int l = it / I_L; int r = it % I_L; unsigned char* wb = C.ws + WS_W + l * W_LAYER;
        if (r < I_IN) { tr_item(gptr(C.in[2]) + (size_t)l * DM * INC, DM, INC, (bf16_t*)(wb + WO_IN), gptr(C.in[1]) + l * DM, scr, r, C.lane); continue; } r -= I_IN;
        if (r < I_OUT) { tr_item(gptr(C.in[14]) + (size_t)l * DM * DM, DM, DM, (bf16_t*)(wb + WO_OUT), nullptr, scr, r, C.lane); continue; } r -= I_OUT;
        if (r < I_UP) { tr_item(gptr(C.in[16]) + (size_t)l * DM * FF, DM, FF, (bf16_t*)(wb + WO_UP), gptr(C.in[15]) + l * DM, scr, r, C.lane); continue; } r -= I_UP;
        tr_item(gptr(C.in[17]) + (size_t)l * FF * DM, FF, DM, (bf16_t*)(wb + WO_DN), nullptr, scr, r, C.lane);
    }
    const float* x = gptr(C.in[0]); bf16_t* xb = (bf16_t*)(C.ws + WS_XB); u64* ssq0 = (u64*)(C.ws + WS_SSQ);
    for (int m0 = gw * 4; m0 < M; m0 += NGW * 4) {
        f32x4 v[4][4]; float sq[4];
#pragma unroll
        for (int r = 0; r < 4; ++r) { const f32x4* xr = (const f32x4*)(x + (size_t)(m0 + r) * DM) + 2 * C.lane;
#pragma unroll
            for (int j = 0; j < 2; ++j) { v[r][2 * j] = xr[128 * j]; v[r][2 * j + 1] = xr[128 * j + 1]; } }
#pragma unroll
        for (int r = 0; r < 4; ++r) { float s = 0.f;
#pragma unroll
            for (int j = 0; j < 4; ++j) s += (v[r][j].x * v[r][j].x + v[r][j].y * v[r][j].y) + (v[r][j].z * v[r][j].z + v[r][j].w * v[r][j].w);
            sq[r] = wave_sum(s); }
#pragma unroll
        for (int r = 0; r < 4; ++r) {
            if (C.lane == 0) ssq0[m0 + r] = (u64)(sq[r] * 16777216.0f);
            u32x4* o16 = (u32x4*)(xb + (size_t)(m0 + r) * DM) + C.lane;
#pragma unroll
            for (int j = 0; j < 2; ++j) { u32x4 w; w.x = pk2(v[r][2 * j].x, v[r][2 * j].y); w.y = pk2(v[r][2 * j].z, v[r][2 * j].w); w.z = pk2(v[r][2 * j + 1].x, v[r][2 * j + 1].y); w.w = pk2(v[r][2 * j + 1].z, v[r][2 * j + 1].w); o16[64 * j] = w; } }
    }
}

struct MixCtx { const bf16_t* Z; bf16_t* MIX; bf16_t* AO; float* LSE; bf16_t* Y2; float* SUM; const bf16_t* WTG; const float* const* in; int l; };
__device__ __forceinline__ MixCtx mk_mix(unsigned char* ws, const float* const* in, int l) { ws = launder(ws); asm volatile("" : "+s"(l));
    MixCtx X; X.Z = (const bf16_t*)(ws + WS_Z); X.MIX = (bf16_t*)(ws + WS_MIX); X.AO = (bf16_t*)(ws + WS_AO); X.LSE = (float*)(ws + WS_LSE); X.Y2 = (bf16_t*)(ws + WS_Y2); X.SUM = (float*)(ws + WS_SUM); X.WTG = (const bf16_t*)(ws + WS_WTG); X.in = in; X.l = l; return X; }

struct AttnPre { u32x4 k[4], v[4]; bf16x8 q0, q1; };
__device__ __forceinline__ void attn_load(const bf16_t* Z, int a, int tid, AttnPre& P) {
    const int lane = tid & 63, w = tid >> 6;
    const int b = a / 96, rem = a % 96, h = rem >> 4, u16 = rem & 15;
    const int sh = 2 * (h >> 1), dil = 1 << sh, nbm = (16 >> sh) - 1;
    const int r = u16 >> (4 - sh), n = u16 & nbm;
    const bf16_t* zb = Z + (size_t)b * SEQ * INC;
#pragma unroll
    for (int i = 0; i < 4; ++i) { const int c = tid + 512 * i; const int row = c >> 3, ch = c & 7; const int sub = (n - 1) * 128 + row;
        P.k[i] = (u32x4){0u, 0u, 0u, 0u}; P.v[i] = (u32x4){0u, 0u, 0u, 0u};
        if (sub >= 0) { const size_t off = (size_t)(sub * dil + r) * INC + h * 64 + ch * 8; P.k[i] = *(const u32x4*)(zb + off + K0); P.v[i] = *(const u32x4*)(zb + off + V0); } }
    const int j = lane & 15, kq = lane >> 4; const int qi = 16 * w + j; const int qpos = (n * 128 + qi) * dil + r;
    const bf16_t* qp = zb + (size_t)qpos * INC + Q0 + h * 64 + kq * 8;
    P.q0 = *(const bf16x8*)qp; P.q1 = *(const bf16x8*)(qp + 32);
}
__device__ __forceinline__ void attn_compute(const MixCtx& X, int a, LAS unsigned char* lds, int tid, const bf16x8 q0, const bf16x8 q1) {
    const int lane = tid & 63, w = __builtin_amdgcn_readfirstlane(tid >> 6);
    const int b = a / 96, rem = a % 96, h = rem >> 4, u16 = rem & 15;
    const int sh = 2 * (h >> 1), dil = 1 << sh, nbm = (16 >> sh) - 1;
    const int r = u16 >> (4 - sh), n = u16 & nbm;
    const float slope = exp2f(-8.0f * (float)(h + 1) / 6.0f);
    const float c1 = 0.125f * LOG2E, c2 = slope * (float)dil * LOG2E;
    LAS unsigned char* Kl = lds; LAS unsigned char* Vl = lds + 39168;
    const int j = lane & 15, kq = lane >> 4;
    const int qi = 16 * w + j; const int qpos = (n * 128 + qi) * dil + r;
    float s[9][4]; float mx = -1e30f;
    const int d0 = j + 128 - 4 * kq;
    float be[4]; const float bstep = 16.0f * c2;
#pragma unroll
    for (int e = 0; e < 4; ++e) be[e] = -c2 * (float)(d0 - e);
    const int nlive0 = (n == 0) ? (8 - w) : 0;
#pragma unroll
    for (int tt = 0; tt < 9; ++tt) {
        if (tt >= nlive0) {
            const int kt = w + tt; const LAS unsigned char* p = Kl + (16 * kt + j) * 144 + kq * 16;
            const bf16x8 k0f = *(const LAS bf16x8*)p, k1f = *(const LAS bf16x8*)(p + 64);
            f32x4 acc = (f32x4){0.f, 0.f, 0.f, 0.f};
            acc = __builtin_amdgcn_mfma_f32_16x16x32_bf16(k0f, q0, acc, 0, 0, 0);
            acc = __builtin_amdgcn_mfma_f32_16x16x32_bf16(k1f, q1, acc, 0, 0, 0);
#pragma unroll
            for (int e = 0; e < 4; ++e) {
                float v = acc[e] * c1 + (be[e] + bstep * (float)tt);
                if (tt == 0) { if (d0 - e > 128) v = -1e30f; }
                if (tt == 8) { if (d0 - 128 - e < 0) v = -1e30f; }
                s[tt][e] = v; mx = fmaxf(mx, v); }
        } else {
#pragma unroll
            for (int e = 0; e < 4; ++e) s[tt][e] = -1e30f;
        }
    }
    mx = fmaxf(mx, __shfl_xor(mx, 16)); mx = fmaxf(mx, __shfl_xor(mx, 32));
    float l = 0.f;
#pragma unroll
    for (int tt = 0; tt < 9; ++tt) {
        if (tt >= nlive0) {
#pragma unroll
            for (int e = 0; e < 4; ++e) { const float pv = __builtin_amdgcn_exp2f(s[tt][e] - mx); s[tt][e] = pv; l += pv; }
        } else {
#pragma unroll
            for (int e = 0; e < 4; ++e) s[tt][e] = 0.f;
        }
    }
    l += __shfl_xor(l, 16); l += __shfl_xor(l, 32);
    f32x4 o[4];
#pragma unroll
    for (int dt = 0; dt < 4; ++dt) o[dt] = (f32x4){0.f, 0.f, 0.f, 0.f};
    const int qq = (lane & 15) >> 2, pp = lane & 3;
#pragma unroll
    for (int c = 0; c < 5; ++c) {
        if (2 * c + 1 >= nlive0) {
            u32x4 pw; pw.x = cvt_pk_bf16(s[2 * c][0], s[2 * c][1]); pw.y = cvt_pk_bf16(s[2 * c][2], s[2 * c][3]);
            if (c < 4) { pw.z = cvt_pk_bf16(s[2 * c + 1][0], s[2 * c + 1][1]); pw.w = cvt_pk_bf16(s[2 * c + 1][2], s[2 * c + 1][3]); } else { pw.z = 0u; pw.w = 0u; }
            const bf16x8 pb = __builtin_bit_cast(bf16x8, pw);
            const int row = 16 * (w + 2 * c) + 4 * kq + qq;
#pragma unroll
            for (int dt = 0; dt < 4; ++dt) {
                LAS unsigned char* vp = Vl + row * 160 + (16 * dt + 4 * pp) * 2;
                const v4i16_t lo = __builtin_amdgcn_ds_read_tr16_b64_v4i16((LAS v4i16_t*)vp);
                const v4i16_t hi = __builtin_amdgcn_ds_read_tr16_b64_v4i16((LAS v4i16_t*)(vp + 16 * 160));
                const bf16x8 vf = (bf16x8){lo[0], lo[1], lo[2], lo[3], hi[0], hi[1], hi[2], hi[3]};
                o[dt] = __builtin_amdgcn_mfma_f32_16x16x32_bf16(vf, pb, o[dt], 0, 0, 0);
            }
        }
    }
    const float inv = 1.0f / l;
    bf16_t* op = X.AO + ((size_t)b * SEQ + qpos) * AW + h * 64 + 4 * kq;
#pragma unroll
    for (int dt = 0; dt < 4; ++dt) { u32x2 wv; wv.x = cvt_pk_bf16(o[dt][0] * inv, o[dt][1] * inv); wv.y = cvt_pk_bf16(o[dt][2] * inv, o[dt][3] * inv); *(u32x2*)(op + 16 * dt) = wv; }
    if (kq == 0) X.LSE[((size_t)b * SEQ + qpos) * 6 + h] = (mx + __log2f(l)) * LN2;
}
__device__ __forceinline__ void attn_loop(unsigned char* ws_, const float* const* in_, int l_, LAS unsigned char* lds, int tid, int a_start, int a_cnt, int a_stride) {
    const MixCtx X = mk_mix(ws_, in_, l_); tid = launder_v(tid);
    LAS unsigned char* Kl = lds; LAS unsigned char* Vl = lds + 39168;
    if (tid < 128) { const int row = 256 + (tid >> 3), ch = tid & 7; const unsigned z = (unsigned)launder_v(0); const u32x4 zz = (u32x4){z, z, z, z}; *(LAS u32x4*)(Kl + row * 144 + ch * 16) = zz; *(LAS u32x4*)(Vl + row * 160 + ch * 16) = zz; }
    AttnPre P; int a = a_start;
    if (a_cnt > 0) attn_load(X.Z, a, tid, P);
    for (int k = 0; k < a_cnt; ++k, a += a_stride) {
        __syncthreads();
#pragma unroll
        for (int i = 0; i < 4; ++i) { const int c = tid + 512 * i; const int row = c >> 3, ch = c & 7;
            *(LAS u32x4*)(Kl + row * 144 + ch * 16) = P.k[i]; *(LAS u32x4*)(Vl + row * 160 + ch * 16) = P.v[i]; }
        const bf16x8 q0 = P.q0, q1 = P.q1;
        __syncthreads();
        if (k + 1 < a_cnt) attn_load(X.Z, a + a_stride, tid, P);
        attn_compute(X, a, lds, tid, q0, q1);
    }
    __syncthreads();
}

__device__ __forceinline__ void conv_glu8(const u32x4 av, const u32x4 gv, f32x4& u0, f32x4& u1) {
    u0[0] = bf_lo(av.x) * sigmoidf_(bf_lo(gv.x)); u0[1] = bf_hi(av.x) * sigmoidf_(bf_hi(gv.x)); u0[2] = bf_lo(av.y) * sigmoidf_(bf_lo(gv.y)); u0[3] = bf_hi(av.y) * sigmoidf_(bf_hi(gv.y));
    u1[0] = bf_lo(av.z) * sigmoidf_(bf_lo(gv.z)); u1[1] = bf_hi(av.z) * sigmoidf_(bf_hi(gv.z)); u1[2] = bf_lo(av.w) * sigmoidf_(bf_lo(gv.w)); u1[3] = bf_hi(av.w) * sigmoidf_(bf_hi(gv.w));
}
__device__ __forceinline__ int ring94(int r) { return r >= 94 ? r - 94 : r; }
template <int S> struct ConvStep {
    static __device__ __forceinline__ void run(float (&acc)[32], const float (&wv)[31], const LAS float* U, int rb, int cch) {
        const float uv = U[ring94(ring94(rb + S)) * 256 + cch];
#pragma unroll
        for (int o = 0; o < 32; ++o) { constexpr int dummy = 0; const int kk = S - o + dummy; if (kk >= 0 && kk <= 30) acc[o] += wv[kk] * uv; }
        ConvStep<S + 1>::run(acc, wv, U, rb, cch);
    }
};
template <> struct ConvStep<62> { static __device__ __forceinline__ void run(float (&)[32], const float (&)[31], const LAS float*, int, int) {} };
__device__ __forceinline__ void conv_loop(unsigned char* ws_, const float* const* in_, int l_, LAS unsigned char* lds, int tid, int bid, int G) {
    const MixCtx X = mk_mix(ws_, in_, l_); tid = launder_v(tid);
    const int lane = tid & 63, w = tid >> 6;
    LAS float* U = (LAS float*)lds;
    const int cch = tid & 255, half = tid >> 8;
    const float* cw = gptr(X.in[3]) + (size_t)X.l * 31 * CW; float wv[31]; int cwo = cch;
#pragma unroll
    for (int k = 0; k < 31; ++k) { wv[k] = cw[cwo]; cwo += CW; asm volatile("" : "+v"(cwo)); }
    const float bias = gptr(X.in[4])[X.l * CW + cch];
    const f32x4 gg = *(const f32x4*)(gptr(X.in[5]) + X.l * CW + 4 * lane), bb = *(const f32x4*)(gptr(X.in[6]) + X.l * CW + 4 * lane);
    for (int cc = bid; cc < BATCH * 8; cc += G) {
        const int b = cc >> 3, tb = (cc & 7) * 4;
        const bf16_t* zb = X.Z + (size_t)b * SEQ * INC;
        u32x4 pa[4], pg[4];
#pragma unroll
        for (int i = 0; i < 4; ++i) { const int idx = tid + 512 * i; const int row = idx >> 5, ch = idx & 31; const size_t t = (size_t)(tb * 64 + row);
            pa[i] = *(const u32x4*)(zb + t * INC + CA0 + ch * 8); pg[i] = *(const u32x4*)(zb + t * INC + CG0 + ch * 8); }
        __syncthreads();
#pragma unroll
        for (int i = 0; i < 2; ++i) { const int idx = tid + 512 * i; if (idx < 30 * 32) { const int row = idx >> 5, ch = idx & 31; const int t = tb * 64 - 30 + row;
            f32x4 u0 = (f32x4){0.f, 0.f, 0.f, 0.f}, u1 = u0;
            if (t >= 0) { const u32x4 av = *(const u32x4*)(zb + (size_t)t * INC + CA0 + ch * 8), gv = *(const u32x4*)(zb + (size_t)t * INC + CG0 + ch * 8); conv_glu8(av, gv, u0, u1); }
            *(LAS f32x4*)(U + row * 256 + ch * 8) = u0; *(LAS f32x4*)(U + row * 256 + ch * 8 + 4) = u1; } }
        int base = 0;
        for (int k = 0; k < 4; ++k) {
            const int t0 = (tb + k) * 64;
#pragma unroll
            for (int i = 0; i < 4; ++i) { const int idx = tid + 512 * i; const int row = ring94(base + 30 + (idx >> 5)), ch = idx & 31; f32x4 u0, u1; conv_glu8(pa[i], pg[i], u0, u1);
                *(LAS f32x4*)(U + row * 256 + ch * 8) = u0; *(LAS f32x4*)(U + row * 256 + ch * 8 + 4) = u1; }
            __syncthreads();
            if (k < 3) {
#pragma unroll
                for (int i = 0; i < 4; ++i) { const int idx = tid + 512 * i; const int row = idx >> 5, ch = idx & 31; const size_t t = (size_t)(t0 + 64 + row);
                    pa[i] = *(const u32x4*)(zb + t * INC + CA0 + ch * 8); pg[i] = *(const u32x4*)(zb + t * INC + CG0 + ch * 8); }
            }
            float acc[32];
#pragma unroll
            for (int o = 0; o < 32; ++o) acc[o] = bias;
            const int rb = base + 32 * half;
            ConvStep<0>::run(acc, wv, U, rb, cch);
            __syncthreads();
#pragma unroll
            for (int o = 0; o < 32; ++o) U[ring94(ring94(rb + o)) * 256 + cch] = acc[o];
            __syncthreads();
#pragma unroll
            for (int i = 0; i < 8; ++i) { const int tok = 8 * w + i; f32x4 v = *(LAS f32x4*)(U + ring94(base + tok) * 256 + 4 * lane);
                const float mean = wave_sum((v[0] + v[1]) + (v[2] + v[3])) * (1.0f / 256.0f);
                v = v - mean; const float var = wave_sum((v[0] * v[0] + v[1] * v[1]) + (v[2] * v[2] + v[3] * v[3])) * (1.0f / 256.0f);
                const float rstd = rsqrtf(var + LN_EPS); f32x4 y = v * rstd * gg + bb;
#pragma unroll
                for (int e = 0; e < 4; ++e) y[e] = y[e] * sigmoidf_(y[e]);
                u32x2 wv2; wv2.x = cvt_pk_bf16(y[0], y[1]); wv2.y = cvt_pk_bf16(y[2], y[3]);
                *(u32x2*)(X.MIX + ((size_t)b * SEQ + t0 + tok) * DM + AW + 4 * lane) = wv2; }
            __syncthreads();
            base = ring94(base + 64);
        }
    }
}

constexpr int LR_UB = 0, LR_A = 18432, LR_B = 53248, LR_WT = 88064, LR_PRM = 106496, LR_SA = 107264, LR_SB = 109312, LR_GT = 111360, LR_CAR = 129792;
__device__ __forceinline__ float gelu_tanh(float x) { const float y = 0.7978845608028654f * (x + 0.044715f * x * x * x); const float e = __expf(2.f * y); return 0.5f * x * (2.f - 2.f * __builtin_amdgcn_rcpf(1.f + e)); }
struct LruPre { u32x4 x[5], g[2]; };
__device__ __forceinline__ void lru_load(const MixCtx& X, int b, int h, int chunk, int tid, LruPre& P) {
    const int c0 = h * 64, t0 = chunk * 128;
    const bf16_t* zb = X.Z + (size_t)b * SEQ * INC; const int cg8 = tid & 7, tp = tid >> 3;
#pragma unroll
    for (int rr = 0; rr < 5; ++rr) { const int t = t0 + 2 * tp - 3 + rr; P.x[rr] = (u32x4){0u, 0u, 0u, 0u}; if (t >= 0) P.x[rr] = *(const u32x4*)(zb + (size_t)t * INC + LX0 + c0 + 8 * cg8); }
#pragma unroll
    for (int i = 0; i < 2; ++i) { const int idx = tid + 512 * i; const int row = idx >> 3, ch = idx & 7;
        P.g[i] = *(const u32x4*)(zb + (size_t)(t0 + row) * INC + LG0 + c0 + ch * 8); }
}
__device__ __forceinline__ void lru_chain(unsigned char* ws_, const float* const* in_, int l_, LAS unsigned char* lds, int tid, int bid, int G) {
    const MixCtx X = mk_mix(ws_, in_, l_); tid = launder_v(tid);
    const int lane = tid & 63, w = __builtin_amdgcn_readfirstlane(tid >> 6); const int l = X.l;
    LAS unsigned char* UB = lds + LR_UB; LAS float* A_ = (LAS float*)(lds + LR_A); LAS float* B_ = (LAS float*)(lds + LR_B);
    LAS unsigned char* WT = lds + LR_WT; LAS float* PRM = (LAS float*)(lds + LR_PRM); LAS float* SA = (LAS float*)(lds + LR_SA); LAS float* SB = (LAS float*)(lds + LR_SB); LAS unsigned char* GT = lds + LR_GT;
    LAS float* CAR = (LAS float*)(lds + LR_CAR);
    const int cg8 = tid & 7, tp = tid >> 3; const int j = lane & 15, kq = lane >> 4;
    for (int chain = bid; chain < BATCH * 6; chain += G) {
        const int b = chain / 6, h = chain % 6, c0 = h * 64;
        LruPre P; lru_load(X, b, h, 0, tid, P);
        f32x4 cwv[4][2], cbv[2];
#pragma unroll
        for (int e2 = 0; e2 < 2; ++e2) { cbv[e2] = *(const f32x4*)(gptr(X.in[8]) + l * LW + c0 + 8 * cg8 + 4 * e2);
#pragma unroll
            for (int k = 0; k < 4; ++k) cwv[k][e2] = *(const f32x4*)(gptr(X.in[7]) + (size_t)(l * 4 + k) * LW + c0 + 8 * cg8 + 4 * e2); }
        __syncthreads();
#pragma unroll
        for (int i = 0; i < 2; ++i) { const int idx = tid + 512 * i; const int row = idx >> 3, ch = idx & 7;
            *(LAS u32x4*)(WT + row * 144 + ch * 16) = *(const u32x4*)(X.WTG + (size_t)(l * 6 + h) * 8192 + idx * 8); }
        if (tid < 64) { PRM[tid] = gptr(X.in[10])[l * LW + c0 + tid]; PRM[64 + tid] = gptr(X.in[12])[l * LW + c0 + tid]; PRM[128 + tid] = log1pf(__expf(-gptr(X.in[13])[l * LW + c0 + tid])); CAR[tid] = 0.f; }
        LAS unsigned char* OT = lds + LR_A;
        for (int chunk = 0; chunk < 16; ++chunk) {
            const int t0 = chunk * 128;
            if (chunk > 0) {
#pragma unroll
                for (int i = 0; i < 2; ++i) { const int idx = tid + 512 * i; const int row = idx >> 3, ch = idx & 7;
                    *(u32x4*)(X.MIX + ((size_t)b * SEQ + t0 - 128 + row) * DM + AW + CW + c0 + ch * 8) = *(const LAS u32x4*)(OT + row * 144 + ch * 16); }
            }
#pragma unroll
            for (int i = 0; i < 2; ++i) { const int idx = tid + 512 * i; const int row = idx >> 3, ch = idx & 7; *(LAS u32x4*)(GT + row * 144 + ch * 16) = P.g[i]; }
            { f32x4 xv[5][2];
#pragma unroll
              for (int rr = 0; rr < 5; ++rr) { const u32x4 v = P.x[rr]; xv[rr][0] = (f32x4){bf_lo(v.x), bf_hi(v.x), bf_lo(v.y), bf_hi(v.y)}; xv[rr][1] = (f32x4){bf_lo(v.z), bf_hi(v.z), bf_lo(v.w), bf_hi(v.w)}; }
#pragma unroll
              for (int tk = 0; tk < 2; ++tk) { f32x4 u0 = cbv[0], u1 = cbv[1];
#pragma unroll
                  for (int k = 0; k < 4; ++k) { u0 += cwv[k][0] * xv[tk + k][0]; u1 += cwv[k][1] * xv[tk + k][1]; }
                  const int tok = 2 * tp + tk;
                  u32x4 pw; pw.x = cvt_pk_bf16(u0[0], u0[1]); pw.y = cvt_pk_bf16(u0[2], u0[3]); pw.z = cvt_pk_bf16(u1[0], u1[1]); pw.w = cvt_pk_bf16(u1[2], u1[3]);
                  *(LAS u32x4*)(UB + tok * 144 + cg8 * 16) = pw;
                  *(LAS f32x4*)(B_ + tok * 68 + cg8 * 8) = u0; *(LAS f32x4*)(B_ + tok * 68 + cg8 * 8 + 4) = u1; } }
            __syncthreads();
            if (chunk < 15) lru_load(X, b, h, chunk + 1, tid, P);
            { const int tok = 16 * w + j; bf16x8 bfr[2];
#pragma unroll
              for (int c = 0; c < 2; ++c) bfr[c] = *(const LAS bf16x8*)(UB + tok * 144 + kq * 16 + c * 64);
#pragma unroll
              for (int ot = 0; ot < 4; ++ot) { f32x4 da = (f32x4){0.f, 0.f, 0.f, 0.f}, dx = da;
#pragma unroll
                  for (int c = 0; c < 2; ++c) { const bf16x8 fa = *(const LAS bf16x8*)(WT + (16 * ot + j) * 144 + kq * 16 + c * 64), fx = *(const LAS bf16x8*)(WT + (64 + 16 * ot + j) * 144 + kq * 16 + c * 64);
                      da = __builtin_amdgcn_mfma_f32_16x16x32_bf16(fa, bfr[c], da, 0, 0, 0); dx = __builtin_amdgcn_mfma_f32_16x16x32_bf16(fx, bfr[c], dx, 0, 0, 0); }
                  const int ch = 16 * ot + 4 * kq;
                  const f32x4 ba4 = *(const LAS f32x4*)(PRM + ch), bx4 = *(const LAS f32x4*)(PRM + 64 + ch), sp4 = *(const LAS f32x4*)(PRM + 128 + ch);
                  const f32x4 u4 = *(const LAS f32x4*)(B_ + tok * 68 + ch); f32x4 a4, b4;
#pragma unroll
                  for (int e = 0; e < 4; ++e) { const float rg = sigmoidf_(da[e] + ba4[e]), ig = sigmoidf_(dx[e] + bx4[e]); const float la = -8.0f * rg * sp4[e];
                      const float av_ = __expf(la); a4[e] = av_; b4[e] = sqrtf(fmaxf(1.0f - av_ * av_, 0.f)) * ig * u4[e]; }
                  *(LAS f32x4*)(A_ + tok * 68 + ch) = a4; *(LAS f32x4*)(B_ + tok * 68 + ch) = b4; } }
            __syncthreads();
            float av[16], bv[16]; float hh = 0.f, aa = 1.f;
#pragma unroll
            for (int i = 0; i < 16; ++i) { av[i] = A_[(16 * w + i) * 68 + lane]; bv[i] = B_[(16 * w + i) * 68 + lane]; hh = av[i] * hh + bv[i]; aa *= av[i]; }
            SA[w * 64 + lane] = aa; SB[w * 64 + lane] = hh;
            __syncthreads();
            float hin = CAR[(chunk & 1) * 64 + lane];
            for (int sgi = 0; sgi < w; ++sgi) hin = SA[sgi * 64 + lane] * hin + SB[sgi * 64 + lane];
            hh = hin;
#pragma unroll
            for (int i = 0; i < 16; i += 2) { hh = av[i] * hh + bv[i]; const float h0 = hh; hh = av[i + 1] * hh + bv[i + 1]; const int tl = 16 * w + i;
                const float g0 = gelu_tanh(bf2f(*(const LAS bf16_t*)(GT + tl * 144 + lane * 2))), g1 = gelu_tanh(bf2f(*(const LAS bf16_t*)(GT + (tl + 1) * 144 + lane * 2)));
                const unsigned pk = cvt_pk_bf16(g0 * h0, g1 * hh);
                *(LAS bf16_t*)(OT + tl * 144 + lane * 2) = (bf16_t)(pk & 0xffffu); *(LAS bf16_t*)(OT + (tl + 1) * 144 + lane * 2) = (bf16_t)(pk >> 16); }
            if (w == 7) CAR[((chunk + 1) & 1) * 64 + lane] = hh;
            __syncthreads();
        }
#pragma unroll
        for (int i = 0; i < 2; ++i) { const int idx = tid + 512 * i; const int row = idx >> 3, ch = idx & 7;
            *(u32x4*)(X.MIX + ((size_t)b * SEQ + 15 * 128 + row) * DM + AW + CW + c0 + ch * 8) = *(const LAS u32x4*)(OT + row * 144 + ch * 16); }
    }
}

__device__ __forceinline__ void mixer_phase(const Ctx& C, int l) {
    lru_chain(C.ws, C.in, l, C.lds, C.tid, C.bid, C.G);
    int a_start, a_cnt, a_stride;
    if (C.G == 256) { if (C.bid >= 192) { a_start = (C.bid - 192) * 27; a_cnt = 27; } else { a_start = 64 * 27 + C.bid * 7; a_cnt = 7; } a_stride = 1; }
    else { a_start = C.bid; a_stride = C.G; a_cnt = (N_ATT - C.bid + C.G - 1) / C.G; }
    attn_loop(C.ws, C.in, l, C.lds, C.tid, a_start, a_cnt, a_stride);
    conv_loop(C.ws, C.in, l, C.lds, C.tid, C.bid, C.G);
}

__device__ __forceinline__ void alpha_phase(const Ctx& C) {
    const bf16_t* AO = (const bf16_t*)(C.ws + WS_AO); bf16_t* MIX = (bf16_t*)(C.ws + WS_MIX); const float* LSE = (const float*)(C.ws + WS_LSE);
    const int gw = C.bid * 8 + C.wave, NGW = C.G * 8;
    for (int tg = gw; tg < M / 4; tg += NGW) {
#pragma unroll
        for (int i = 0; i < 3; ++i) { const int L = C.lane + 64 * i; const size_t tok = (size_t)4 * tg + L / 48; const int ch = L % 48, h = ch >> 3, jj = h & 1, g = h >> 1;
            const float l0 = LSE[tok * 6 + jj], l1 = LSE[tok * 6 + 2 + jj], l2 = LSE[tok * 6 + 4 + jj];
            const float mx = fmaxf(l0, fmaxf(l1, l2)); const float e0 = __expf(l0 - mx), e1 = __expf(l1 - mx), e2 = __expf(l2 - mx);
            const float al = (g == 0 ? e0 : (g == 1 ? e1 : e2)) / (e0 + e1 + e2);
            const u32x4 v = *(const u32x4*)(AO + tok * AW + ch * 8); u32x4 o;
            o.x = pk2(bf_lo(v.x) * al, bf_hi(v.x) * al); o.y = pk2(bf_lo(v.y) * al, bf_hi(v.y) * al); o.z = pk2(bf_lo(v.z) * al, bf_hi(v.z) * al); o.w = pk2(bf_lo(v.w) * al, bf_hi(v.w) * al);
            *(u32x4*)(MIX + tok * DM + ch * 8) = o; }
    }
}

__device__ __forceinline__ void final_phase(const Ctx& C) {
    const u64* ssq = (const u64*)(C.ws + WS_SSQ) + 4 * (size_t)M; const float* g = gptr(C.in[18]);
    const int gw = C.bid * 8 + C.wave, NGW = C.G * 8;
    f32x4 gv[4];
#pragma unroll
    for (int j = 0; j < 2; ++j) { gv[2 * j] = *((const f32x4*)g + 2 * C.lane + 128 * j); gv[2 * j + 1] = *((const f32x4*)g + 2 * C.lane + 128 * j + 1); }
    const bf16_t* XB = (const bf16_t*)(C.ws + WS_XB);
    for (int m0 = gw * 4; m0 < M; m0 += NGW * 4) {
        u32x4 v[4][2]; float ri[4];
#pragma unroll
        for (int r = 0; r < 4; ++r) { ri[r] = rinv_from(__hip_atomic_load(ssq + m0 + r, __ATOMIC_RELAXED, __HIP_MEMORY_SCOPE_AGENT)); const u32x4* xi = (const u32x4*)(XB + (size_t)(m0 + r) * DM) + C.lane;
#pragma unroll
            for (int j = 0; j < 2; ++j) v[r][j] = xi[64 * j]; }
#pragma unroll
        for (int r = 0; r < 4; ++r) { f32x4* xr = (f32x4*)(C.out + (size_t)(m0 + r) * DM) + 2 * C.lane;
#pragma unroll
            for (int j = 0; j < 2; ++j) { const u32x4 q = v[r][j];
                xr[128 * j] = (f32x4){bf_lo(q.x), bf_hi(q.x), bf_lo(q.y), bf_hi(q.y)} * ri[r] * gv[2 * j];
                xr[128 * j + 1] = (f32x4){bf_lo(q.z), bf_hi(q.z), bf_lo(q.w), bf_hi(q.w)} * ri[r] * gv[2 * j + 1]; } }
    }
}

constexpr int N_PHASES = 14;
__global__ void __launch_bounds__(512, 2) fwd_kernel(Args args) {
    extern __shared__ __attribute__((aligned(16))) unsigned char lds_raw[];
#define IN(k) (true)
#define MKCTX Ctx C; C.in = args.in; C.out = (float*)launder((unsigned char*)args.out); C.ws = launder(args.ws); C.lds = (LAS unsigned char*)lds_raw; \
    C.tid = launder_v((int)threadIdx.x); C.lane = C.tid & 63; C.wave = __builtin_amdgcn_readfirstlane(C.tid >> 6); C.G = gridDim.x; C.bid = blockIdx.x;
    LAS unsigned char* const ldsp = (LAS unsigned char*)lds_raw; const int G_ = gridDim.x, bid_ = blockIdx.x;
#define SYNC(k) do { xcd_barrier(xbar); } while (0)
    { volatile LAS unsigned* misc = (volatile LAS unsigned*)(lds_raw + MISC_OFF); if (threadIdx.x < 16) misc[threadIdx.x] = 0u; __syncthreads(); }
    if (IN(0)) { MKCTX; prologue(C); }
    cg::this_grid().sync();
    XcdBarrier xbar = xcd_barrier_post((unsigned*)(args.ws + WS_BAR), (volatile LAS unsigned*)((LAS unsigned char*)lds_raw + MISC_OFF + 32));
    for (int l = 0; l < 2; ++l) {
        asm volatile("" : "+s"(l));
        const int pb = 1 + 6 * l;
        if (IN(pb)) {
            unsigned char* ws = launder(args.ws); unsigned char* wb = ws + WS_W + l * W_LAYER;
            pg8::Gemm g{(const bf16_t*)(ws + WS_XB), (const bf16_t*)(wb + WO_IN), M, INP, DM}; pg8::StaticOrder S; S.init(M, INP, G_, bid_);
            pg8::EpiRowScale<0> E{(bf16_t*)(ws + WS_Z), INC, (const u64*)(ws + WS_SSQ) + (size_t)(2 * l) * M, INC, ldsp + EPI_STG_OFF};
            pg8::gemm_phase<pg8::EpiRowScale<0>, pg8::StaticOrder, true, true>(ldsp, g, S, E);
        }
        SYNC(pb);
        if (IN(pb + 1)) { MKCTX; mixer_phase(C, l); }
        SYNC(pb + 1);
        if (IN(pb + 2)) { MKCTX; alpha_phase(C); }
        SYNC(pb + 2);
        if (IN(pb + 3)) {
            unsigned char* ws = launder(args.ws); unsigned char* wb = ws + WS_W + l * W_LAYER;
            pg8::Gemm g{(const bf16_t*)(ws + WS_MIX), (const bf16_t*)(wb + WO_OUT), M, DM, DM}; pg8::StaticOrder S; S.init(M, DM, G_, bid_);
            pg8::EpiResid E{(bf16_t*)(ws + WS_XB), (u64*)(ws + WS_SSQ) + (size_t)(2 * l + 1) * M, ldsp + EPI_STG_OFF};
            pg8::gemm_phase<pg8::EpiResid, pg8::StaticOrder, true, true>(ldsp, g, S, E);
        }
        SYNC(pb + 3);
        if (IN(pb + 4)) {
            unsigned char* ws = launder(args.ws); unsigned char* wb = ws + WS_W + l * W_LAYER;
            pg8::Gemm g{(const bf16_t*)(ws + WS_XB), (const bf16_t*)(wb + WO_UP), M, FF, DM}; pg8::StaticOrder S; S.init(M, FF, G_, bid_);
            pg8::EpiRowScale<1> E{(bf16_t*)(ws + WS_BIG), FF, (const u64*)(ws + WS_SSQ) + (size_t)(2 * l + 1) * M, FF, ldsp + EPI_STG_OFF};
            pg8::gemm_phase<pg8::EpiRowScale<1>, pg8::StaticOrder, true, true>(ldsp, g, S, E);
        }
        SYNC(pb + 4);
        if (IN(pb + 5)) {
            unsigned char* ws = launder(args.ws); unsigned char* wb = ws + WS_W + l * W_LAYER;
            pg8::Gemm g{(const bf16_t*)(ws + WS_BIG), (const bf16_t*)(wb + WO_DN), M, DM, FF}; pg8::StaticOrder S; S.init(M, DM, G_, bid_);
            pg8::EpiResid E{(bf16_t*)(ws + WS_XB), (u64*)(ws + WS_SSQ) + (size_t)(2 * l + 2) * M, ldsp + EPI_STG_OFF};
            pg8::gemm_phase<pg8::EpiResid, pg8::StaticOrder, true, true>(ldsp, g, S, E);
        }
        SYNC(pb + 5);
    }
    if (IN(13)) { MKCTX; final_phase(C); }
#undef IN
#undef SYNC
#undef MKCTX
}

extern "C" void kernel_launch(void* const* d_in, const int* in_sizes, int n_in, void* d_out, int out_size, void* d_ws, size_t ws_size, hipStream_t stream) {
    static int grid = 0;
    if (grid == 0) {
        if (n_in != 19 || in_sizes[0] != M * DM || out_size != M * DM || ws_size < WS_END) { fprintf(stderr, "kernel_launch: unexpected shapes (n_in %d, in0 %d, out %d, ws %zu)\n", n_in, n_in > 0 ? in_sizes[0] : -1, out_size, ws_size); grid = -1; return; }
        int dev = 0, cus = 0, per_cu = 0;
        if (hipGetDevice(&dev) != hipSuccess || hipDeviceGetAttribute(&cus, hipDeviceAttributeMultiprocessorCount, dev) != hipSuccess) { grid = -1; return; }
        if (hipFuncSetAttribute((const void*)fwd_kernel, hipFuncAttributeMaxDynamicSharedMemorySize, LDS_BYTES) != hipSuccess) { fprintf(stderr, "kernel_launch: hipFuncSetAttribute failed\n"); grid = -1; return; }
        if (hipOccupancyMaxActiveBlocksPerMultiprocessor(&per_cu, (const void*)fwd_kernel, 512, LDS_BYTES) != hipSuccess || per_cu < 1) { fprintf(stderr, "kernel_launch: occupancy query says %d\n", per_cu); per_cu = 1; }
        (void)hipGetLastError();
        grid = cus * per_cu;
    }
    if (grid < 0) return;
    Args a{};
    for (int i = 0; i < 19; ++i) a.in[i] = (const float*)d_in[i];
    a.out = (float*)d_out; a.ws = (unsigned char*)d_ws;
#if ONE_LAUNCH
    a.ph_lo = 0; a.ph_hi = N_PHASES;
    void* kargs[] = {&a};
    hipError_t e = hipLaunchCooperativeKernel((const void*)fwd_kernel, dim3(grid), dim3(512), kargs, LDS_BYTES, stream);
    if (e != hipSuccess) fprintf(stderr, "cooperative launch failed: %s (grid %d)\n", hipGetErrorString(e), grid);
#else
    for (int p = 0; p < N_PHASES; ++p) { a.ph_lo = p; a.ph_hi = p + 1; hipLaunchKernelGGL(fwd_kernel, dim3(grid), dim3(512), LDS_BYTES, stream, a); }
#endif
}
```

```cpp
#include <hip/hip_runtime.h>
#include <hip/hip_cooperative_groups.h>
#include <cstdio>
#include <cstdint>
namespace cg = cooperative_groups;

#ifndef ONE_LAUNCH
#define ONE_LAUNCH 1
#endif

#define LAS __attribute__((address_space(3)))
typedef unsigned short bf16_t;
typedef short bf16x8 __attribute__((ext_vector_type(8)));
typedef float f32x4 __attribute__((ext_vector_type(4)));
typedef float f32x2 __attribute__((ext_vector_type(2)));
typedef unsigned u32x4 __attribute__((ext_vector_type(4)));
typedef unsigned u32x2 __attribute__((ext_vector_type(2)));
typedef short v4i16_t __attribute__((ext_vector_type(4)));
typedef unsigned long long u64;

constexpr int DM = 1024, BATCH = 32, SEQ = 2048, M = BATCH * SEQ;
constexpr int HD = 64, AW = 384, CW = 256, LW = 384, INC = 2432, INP = 2560, FF = 4096;
constexpr int Q0 = 0, K0 = 384, V0 = 768, CA0 = 1152, CG0 = 1408, LG0 = 1664, LX0 = 2048;
constexpr float RMS_EPS = 1e-6f, LN_EPS = 1e-5f;
constexpr float LOG2E = 1.4426950408889634f, LN2 = 0.6931471805599453f;

constexpr size_t MiB = 1u << 20;
constexpr size_t WS_CTR = 0, WS_BAR = 65536;
constexpr size_t WS_CTR_UNUSED = 0;
constexpr size_t WS_W = 2 * MiB, W_LAYER = 23 * MiB;
constexpr size_t WO_IN = 0, WO_OUT = 5 * MiB, WO_UP = 7 * MiB, WO_DN = 15 * MiB;
constexpr size_t WS_SSQ = 48 * MiB;
constexpr size_t WS_LSE = 51 * MiB;
constexpr size_t WS_XB = 53 * MiB;
constexpr size_t WS_BIG = 181 * MiB;
constexpr size_t WS_Z = WS_BIG, WS_MIX = WS_BIG + 304 * MiB, WS_AO = WS_BIG + 432 * MiB;
constexpr size_t WS_Y2 = WS_BIG + 480 * MiB, WS_SUM = WS_BIG + 528 * MiB;
constexpr size_t WS_WTG = 1 * MiB;
constexpr size_t WS_END = WS_BIG + 530 * MiB;
constexpr int N_LRUC = 6 * BATCH * 16, N_ATT = BATCH * 96;

constexpr int LDS_BYTES = 151552;
constexpr int EPI_STG_OFF = 131072 + 1024, EPI_STG_SLICE = 2304;
constexpr int MISC_OFF = 131072;

__device__ __forceinline__ float bf_lo(unsigned w) { return __uint_as_float(w << 16); }
__device__ __forceinline__ float bf_hi(unsigned w) { return __uint_as_float(w & 0xffff0000u); }
__device__ __forceinline__ float bf2f(bf16_t b) { return __uint_as_float((unsigned)b << 16); }
__device__ __forceinline__ unsigned f2bf(float f) { unsigned u = __float_as_uint(f); return (u + 0x7fffu + ((u >> 16) & 1u)) >> 16; }
__device__ __forceinline__ unsigned pk2(float lo, float hi) { return f2bf(lo) | (f2bf(hi) << 16); }
__device__ __forceinline__ unsigned cvt_pk_bf16(float lo, float hi) { unsigned r; asm volatile("v_cvt_pk_bf16_f32 %0, %1, %2" : "=v"(r) : "v"(lo), "v"(hi)); return r; }
__device__ __forceinline__ float sigmoidf_(float x) { return __builtin_amdgcn_rcpf(1.f + __expf(-x)); }
__device__ __forceinline__ float wave_sum(float v) {
#pragma unroll
    for (int o = 1; o < 64; o <<= 1) v += __shfl_xor(v, o);
    return v;
}
__device__ __forceinline__ float rinv_from(u64 v) { return rsqrtf((float)v * (1.0f / 16777216.0f) * (1.0f / 1024.0f) + RMS_EPS); }

namespace pg8 {
constexpr int BM = 256, BK = 64, HALF = 128, HTB = HALF * BK * 2, STAGE_BYTES = 8 * HTB, NXCD = 8, WGM = 8;
__host__ __device__ __forceinline__ int lds_byte(int r, int c) { const int st = (r >> 4) * 2 + (c >> 5), rr = r & 15, cc = c & 31, ob = rr * 64 + cc * 2; return st * 1024 + (ob ^ (((ob >> 9) & 1) << 5)); }
__host__ __device__ __forceinline__ void stage_rc(int b, int& R, int& C) { const int st = b / 1024, sb = b % 1024, swz = sb ^ (((sb >> 9) & 1) << 5); R = (st >> 1) * 16 + swz / 64; C = (st & 1) * 32 + (swz % 64) / 2; }
__host__ __device__ __forceinline__ int perm32(int rho) { const int n = rho >> 4, i = rho & 15; return 8 * (i >> 2) + 4 * n + (i & 3); }

struct Unit { int pm, pn; };
struct Gemm { const bf16_t* A; const bf16_t* Bt; int M, N, K; };

struct StaticOrder {
    int nM, nN, nwg, G, c;
    __host__ __device__ void init(int M_, int N_, int G_, int c_) { nM = M_ / BM; nN = N_ / BM; nwg = nM * nN; G = G_; c = c_; }
    __host__ __device__ bool next(int i, Unit& u) const {
        const long L = (long)i * G + c; if (L >= nwg) return false;
        int wgid = (int)L; { const int q = nwg / NXCD, r = nwg % NXCD, xcd = wgid % NXCD, off = wgid / NXCD; wgid = (xcd < r ? xcd * (q + 1) : r * (q + 1) + (xcd - r) * q) + off; }
        const int nig = WGM * nN, gid = wgid / nig, fm = gid * WGM, gsz = (nM - fm) < WGM ? (nM - fm) : WGM;
        u.pm = fm + ((wgid % nig) % gsz); u.pn = (wgid % nig) / gsz; return true;
    }
    __device__ __forceinline__ void a_ready(const Unit&) const {}
    __device__ __forceinline__ void done(const Unit&) const {}
};

template <int ACT> struct EpiRowScale {
    static constexpr bool PERM = true, AFTER_DRAIN = false;
    bf16_t* O; int ldc; const u64* ssq; int nvalid; LAS unsigned char* stg;
    __device__ __forceinline__ void operator()(const f32x4 (&acc)[2][2][4][2], const Unit& u, int wr, int wc, int fr, int fq) const {
        const int ln = fr + 16 * fq; const int colw = u.pn * BM + 64 * wc;
        if (colw >= nvalid) return;
        float rl[2];
#pragma unroll
        for (int ai = 0; ai < 2; ++ai) rl[ai] = rinv_from(ssq[u.pm * BM + ai * HALF + wr * 64 + ln]);
        LAS unsigned char* sl = stg + (wr * 4 + wc) * EPI_STG_SLICE;
        const int rr = ln >> 3, cc = ln & 7;
#pragma unroll
        for (int ai = 0; ai < 2; ++ai)
#pragma unroll
            for (int m = 0; m < 4; ++m) {
                const float sc = __shfl(rl[ai], 16 * m + fr);
#pragma unroll
                for (int bj = 0; bj < 2; ++bj) {
                    f32x4 v0 = acc[ai][bj][m][0] * sc, v1 = acc[ai][bj][m][1] * sc;
                    if (ACT == 1) {
#pragma unroll
                        for (int e = 0; e < 4; ++e) { float a = fmaxf(v0[e], 0.f), b = fmaxf(v1[e], 0.f); v0[e] = a * a; v1[e] = b * b; }
                    }
                    u32x4 w; w.x = cvt_pk_bf16(v0[0], v0[1]); w.y = cvt_pk_bf16(v0[2], v0[3]); w.z = cvt_pk_bf16(v1[0], v1[1]); w.w = cvt_pk_bf16(v1[2], v1[3]);
                    *(LAS u32x4*)(sl + fr * 144 + bj * 64 + fq * 16) = w;
                }
                const int rowb = u.pm * BM + ai * HALF + wr * 64 + m * 16;
#pragma unroll
                for (int i = 0; i < 2; ++i) { const int r = rr + 8 * i; const u32x4 q = *(const LAS u32x4*)(sl + r * 144 + cc * 16);
                    __builtin_nontemporal_store(q, (u32x4*)(O + (size_t)(rowb + r) * ldc + colw + cc * 8)); }
            }
    }
};
struct EpiResid {
    static constexpr bool PERM = true, AFTER_DRAIN = false;
    bf16_t* xb; u64* ssq; LAS unsigned char* stg;
    __device__ __forceinline__ void operator()(const f32x4 (&acc)[2][2][4][2], const Unit& u, int wr, int wc, int fr, int fq) const {
        const int ln = fr + 16 * fq, rr = ln >> 3, cc = ln & 7; const int colw = u.pn * BM + 64 * wc;
        LAS unsigned char* sl = stg + (wr * 4 + wc) * EPI_STG_SLICE;
#pragma unroll
        for (int ai = 0; ai < 2; ++ai) {
            float qs[4];
#pragma unroll
            for (int mh = 0; mh < 2; ++mh) {
            u32x4 bs[4][2];
#pragma unroll
            for (int m = 2 * mh; m < 2 * mh + 2; ++m) { const int rowb = u.pm * BM + ai * HALF + wr * 64 + m * 16;
#pragma unroll
                for (int i = 0; i < 2; ++i) bs[m][i] = *(const u32x4*)(xb + (size_t)(rowb + rr + 8 * i) * DM + colw + cc * 8); }
#pragma unroll
            for (int m = 2 * mh; m < 2 * mh + 2; ++m) {
                const int rowb = u.pm * BM + ai * HALF + wr * 64 + m * 16; float q = 0.f;
#pragma unroll
                for (int i = 0; i < 2; ++i) *(LAS u32x4*)(sl + (rr + 8 * i) * 144 + cc * 16) = bs[m][i];
#pragma unroll
                for (int bj = 0; bj < 2; ++bj) {
                    const u32x4 b4 = *(const LAS u32x4*)(sl + fr * 144 + bj * 64 + fq * 16);
                    const f32x4 a0 = acc[ai][bj][m][0], a1 = acc[ai][bj][m][1];
                    const float o0 = bf_lo(b4.x) + a0[0], o1 = bf_hi(b4.x) + a0[1], o2 = bf_lo(b4.y) + a0[2], o3 = bf_hi(b4.y) + a0[3];
                    const float o4 = bf_lo(b4.z) + a1[0], o5 = bf_hi(b4.z) + a1[1], o6 = bf_lo(b4.w) + a1[2], o7 = bf_hi(b4.w) + a1[3];
                    q += ((o0 * o0 + o1 * o1) + (o2 * o2 + o3 * o3)) + ((o4 * o4 + o5 * o5) + (o6 * o6 + o7 * o7));
                    u32x4 w; w.x = cvt_pk_bf16(o0, o1); w.y = cvt_pk_bf16(o2, o3); w.z = cvt_pk_bf16(o4, o5); w.w = cvt_pk_bf16(o6, o7);
                    *(LAS u32x4*)(sl + fr * 144 + bj * 64 + fq * 16) = w;
                }
#pragma unroll
                for (int i = 0; i < 2; ++i) { const u32x4 qv = *(const LAS u32x4*)(sl + (rr + 8 * i) * 144 + cc * 16);
                    *(u32x4*)(xb + (size_t)(rowb + rr + 8 * i) * DM + colw + cc * 8) = qv; }
                q += __shfl_xor(q, 16); q += __shfl_xor(q, 32); qs[m] = q;
            }
            asm volatile("" ::: "memory");
            }
            { const float mine = fq == 0 ? qs[0] : (fq == 1 ? qs[1] : (fq == 2 ? qs[2] : qs[3]));
              __hip_atomic_fetch_add(ssq + (u.pm * BM + ai * HALF + wr * 64 + 16 * fq + fr), (u64)(mine * 16777216.0f), __ATOMIC_RELAXED, __HIP_MEMORY_SCOPE_AGENT); }
            asm volatile("" ::: "memory");
        }
    }
};

template <class Epi, class Sched, bool ALIGN_EPI = false, bool SP2 = false>
__device__ __forceinline__ void gemm_phase(LAS unsigned char* lds, const Gemm g, const Sched& S, const Epi& E) {
    int tid_ = (int)threadIdx.x; asm volatile("" : "+v"(tid_));
    const int tid = tid_, wid = __builtin_amdgcn_readfirstlane(tid >> 6), lane = tid & 63, wr = wid >> 2, wc = wid & 3, fr = lane & 15, fq = lane >> 4;
    const int K = g.K, nt = K / BK;
    unsigned voffA[2], voffB[2];
#pragma unroll
    for (int i = 0; i < 2; ++i) { int R, C; stage_rc(tid * 16 + i * 8192, R, C); const int Rb = Epi::PERM ? ((R & ~31) + perm32(R & 31)) : R;
        voffA[i] = (unsigned)(R * K + C) * 2u; voffB[i] = (unsigned)(Rb * K + C) * 2u; }
    const size_t kstep = (size_t)(BK * 2);
    const size_t hstep = (size_t)HALF * K * 2;
    const size_t tstep = 2 * hstep;
    const unsigned ldsw = (unsigned)wid * 1024u;
    const int aoff = lds_byte(wr * 64 + fr, fq * 8), boff = lds_byte(wc * 32 + fr, fq * 8);
#define PG8_SA(b, h) (((b) * 2 + (h)) * HTB)
#define PG8_SB(b, h) ((4 + (b) * 2 + (h)) * HTB)
#define PG8_STAGE(bufoff, gbase, voff) do { _Pragma("unroll") for (int _i = 0; _i < 2; ++_i) \
        __builtin_amdgcn_global_load_lds((const unsigned*)((const char*)(gbase) + (voff)[_i]), (LAS unsigned*)(lds + (bufoff) + ldsw + _i * 8192), 16, 0, 0); } while (0)
#define PG8_LDA(dst, b, h) do { _Pragma("unroll") for (int m = 0; m < 4; ++m) _Pragma("unroll") for (int k = 0; k < 2; ++k) dst[m][k] = *(const LAS bf16x8*)(lds + PG8_SA(b, h) + aoff + m * 2048 + k * 1024); } while (0)
#define PG8_LDB(dst, b, h) do { _Pragma("unroll") for (int n = 0; n < 2; ++n) _Pragma("unroll") for (int k = 0; k < 2; ++k) dst[n][k] = *(const LAS bf16x8*)(lds + PG8_SB(b, h) + boff + n * 2048 + k * 1024); } while (0)
#define PG8_MMA(ai, bj, At, Bt) do { __builtin_amdgcn_s_setprio(1); _Pragma("unroll") for (int m = 0; m < 4; ++m) _Pragma("unroll") for (int n = 0; n < 2; ++n) _Pragma("unroll") for (int k = 0; k < 2; ++k) \
        acc[ai][bj][m][n] = __builtin_amdgcn_mfma_f32_16x16x32_bf16(Bt[n][k], At[m][k], acc[ai][bj][m][n], 0, 0, 0); __builtin_amdgcn_s_setprio(0); } while (0)
#define PG8_WAIT_V(n) asm volatile("s_waitcnt vmcnt(" #n ")" ::: "memory")
#define PG8_WAIT_L(n) asm volatile("s_waitcnt lgkmcnt(" #n ")" ::: "memory")
#define PG8_BAR __builtin_amdgcn_s_barrier()
#define PG8_SCHED __builtin_amdgcn_sched_barrier(0)
    Unit cur, nxt; int ui = 0;
    if (!S.next(0, cur)) return;
    f32x4 acc[2][2][4][2];
#pragma unroll
    for (int a = 0; a < 2; ++a)
#pragma unroll
        for (int b = 0; b < 2; ++b)
#pragma unroll
            for (int m = 0; m < 4; ++m)
#pragma unroll
                for (int n = 0; n < 2; ++n) acc[a][b][m][n] = (f32x4){0.f, 0.f, 0.f, 0.f};
    bf16x8 At[4][2], B0[2][2], B1[2][2];
    const char* cA = (const char*)g.A + (size_t)cur.pm * tstep; const char* cB = (const char*)g.Bt + (size_t)cur.pn * tstep;
    S.a_ready(cur);
    if constexpr (SP2) {
        PG8_STAGE(PG8_SB(0, 0), cB, voffB); PG8_STAGE(PG8_SB(0, 1), cB + hstep, voffB); PG8_STAGE(PG8_SA(0, 0), cA, voffA); PG8_STAGE(PG8_SA(0, 1), cA + hstep, voffA);
        if (wr == 1) PG8_BAR;
        PG8_WAIT_V(2); PG8_BAR;
        PG8_STAGE(PG8_SB(1, 0), cB + kstep, voffB); PG8_STAGE(PG8_SA(1, 0), cA + kstep, voffA); PG8_STAGE(PG8_SB(1, 1), cB + hstep + kstep, voffB);
        PG8_WAIT_V(6); PG8_BAR;
    } else {
        PG8_STAGE(PG8_SB(0, 0), cB, voffB); PG8_STAGE(PG8_SA(0, 0), cA, voffA); PG8_STAGE(PG8_SB(0, 1), cB + hstep, voffB); PG8_STAGE(PG8_SA(0, 1), cA + hstep, voffA);
        if (wr == 1) PG8_BAR;
        PG8_WAIT_V(4); PG8_BAR;
        PG8_STAGE(PG8_SB(1, 0), cB + kstep, voffB); PG8_STAGE(PG8_SA(1, 0), cA + kstep, voffA); PG8_STAGE(PG8_SB(1, 1), cB + hstep + kstep, voffB);
        PG8_WAIT_V(6); PG8_BAR;
    }
    for (;;) {
        const bool has_next = S.next(ui + 1, nxt);
        const char* nA = has_next ? (const char*)g.A + (size_t)nxt.pm * tstep : cA; const char* nB = has_next ? (const char*)g.Bt + (size_t)nxt.pn * tstep : cB;
        for (int t = 0; t < nt; t += 2) {
            const bool last = (t == nt - 2);
            const char* a1 = cA + (size_t)(t + 1) * kstep;
            const char* a2 = last ? nA : cA + (size_t)(t + 2) * kstep; const char* b2 = last ? nB : cB + (size_t)(t + 2) * kstep;
            const char* a3 = a2 + kstep; const char* b3 = b2 + kstep;
            if (last && has_next) S.a_ready(nxt);
            if constexpr (SP2) {
            PG8_LDB(B0, 0, 0); PG8_LDB(B1, 0, 1); PG8_SCHED; PG8_LDA(At, 0, 0); PG8_STAGE(PG8_SA(1, 1), a1 + hstep, voffA);
            PG8_WAIT_V(8); PG8_WAIT_L(0); PG8_BAR; PG8_MMA(0, 0, At, B0); PG8_MMA(0, 1, At, B1); PG8_BAR; PG8_SCHED;
            PG8_LDA(At, 0, 1); PG8_STAGE(PG8_SB(0, 0), b2, voffB); PG8_STAGE(PG8_SB(0, 1), b2 + hstep, voffB); PG8_STAGE(PG8_SA(0, 0), a2, voffA);
            PG8_WAIT_V(8); PG8_WAIT_L(0); PG8_BAR; PG8_MMA(1, 0, At, B0); PG8_MMA(1, 1, At, B1); PG8_BAR; PG8_SCHED;
            PG8_LDB(B0, 1, 0); PG8_LDB(B1, 1, 1); PG8_SCHED; PG8_LDA(At, 1, 0); PG8_STAGE(PG8_SA(0, 1), a2 + hstep, voffA);
            PG8_WAIT_V(8); PG8_WAIT_L(0); PG8_BAR; PG8_MMA(0, 0, At, B0); PG8_MMA(0, 1, At, B1); PG8_BAR; PG8_SCHED;
            PG8_LDA(At, 1, 1); PG8_STAGE(PG8_SB(1, 0), b3, voffB); PG8_STAGE(PG8_SB(1, 1), b3 + hstep, voffB); PG8_STAGE(PG8_SA(1, 0), a3, voffA);
            PG8_WAIT_V(8); PG8_WAIT_L(0); PG8_BAR; PG8_MMA(1, 0, At, B0); PG8_MMA(1, 1, At, B1); PG8_BAR; PG8_SCHED;
            } else {
            PG8_LDB(B0, 0, 0); PG8_SCHED; PG8_LDA(At, 0, 0); PG8_STAGE(PG8_SA(1, 1), a1 + hstep, voffA);
            PG8_WAIT_L(8); PG8_BAR; PG8_WAIT_L(0); PG8_MMA(0, 0, At, B0); PG8_BAR; PG8_SCHED;
            PG8_LDB(B1, 0, 1); PG8_STAGE(PG8_SB(0, 0), b2, voffB);
            PG8_BAR; PG8_WAIT_L(0); PG8_MMA(0, 1, At, B1); PG8_BAR;
            PG8_LDA(At, 0, 1); PG8_STAGE(PG8_SA(0, 0), a2, voffA);
            PG8_BAR; PG8_WAIT_L(0); PG8_MMA(1, 0, At, B0); PG8_BAR; PG8_SCHED;
            PG8_STAGE(PG8_SB(0, 1), b2 + hstep, voffB);
            PG8_WAIT_V(6); PG8_BAR; PG8_MMA(1, 1, At, B1); PG8_BAR;
            PG8_LDB(B0, 1, 0); PG8_SCHED; PG8_LDA(At, 1, 0); PG8_STAGE(PG8_SA(0, 1), a2 + hstep, voffA);
            PG8_WAIT_L(8); PG8_BAR; PG8_WAIT_L(0); PG8_MMA(0, 0, At, B0); PG8_BAR; PG8_SCHED;
            PG8_LDB(B1, 1, 1); PG8_STAGE(PG8_SB(1, 0), b3, voffB);
            PG8_BAR; PG8_WAIT_L(0); PG8_MMA(0, 1, At, B1); PG8_BAR;
            PG8_LDA(At, 1, 1); PG8_STAGE(PG8_SA(1, 0), a3, voffA);
            PG8_BAR; PG8_WAIT_L(0); PG8_MMA(1, 0, At, B0); PG8_BAR; PG8_SCHED;
            PG8_STAGE(PG8_SB(1, 1), b3 + hstep, voffB);
            PG8_WAIT_V(6); PG8_BAR; PG8_MMA(1, 1, At, B1); PG8_BAR;
            }
        }
        if constexpr (ALIGN_EPI) { if (wr == 0) PG8_BAR; }
        if constexpr (!Epi::AFTER_DRAIN) { E(acc, cur, wr, wc, fr, fq); S.done(cur); }
        if (!has_next) break;
#pragma unroll
        for (int a = 0; a < 2; ++a)
#pragma unroll
            for (int b = 0; b < 2; ++b)
#pragma unroll
                for (int m = 0; m < 4; ++m)
#pragma unroll
                    for (int n = 0; n < 2; ++n) acc[a][b][m][n] = (f32x4){0.f, 0.f, 0.f, 0.f};
        cur = nxt; cA = nA; cB = nB; ++ui;
        if constexpr (ALIGN_EPI) { if (wr == 1) PG8_BAR; }
    }
    PG8_WAIT_V(0);
    if constexpr (!ALIGN_EPI) { if (wr == 0) PG8_BAR; }
    PG8_BAR;
#undef PG8_SA
#undef PG8_SB
#undef PG8_STAGE
#undef PG8_LDA
#undef PG8_LDB
#undef PG8_MMA
#undef PG8_WAIT_V
#undef PG8_WAIT_L
#undef PG8_BAR
#undef PG8_SCHED
}
}

typedef __attribute__((address_space(1))) unsigned char gchar_t;
__device__ __forceinline__ unsigned char* launder(unsigned char* p) { size_t z = 0; asm volatile("" : "+s"(z)); return p + z; }
__device__ __forceinline__ const float* gptr(const float* p) { return (const float*)(const __attribute__((address_space(1))) float*)p; }
__device__ __forceinline__ int launder_v(int x) { asm volatile("" : "+v"(x)); return x; }

#define XB_TMO      128
#define XB_XCNT(j)  (256  + 64 * (j))
#define XB_XSUB(j)  (1280 + 64 * (j))
#define XB_XGEN(j)  (2304 + 64 * (j))
#define XB_TOP      3328
#define XB_TOPGEN   3392
#define XCD_BAR_WORDS 3456
#define XB_SPIN_CAP (1u << 18)
__device__ __forceinline__ unsigned xb_ld(unsigned* p)              { return __hip_atomic_load(p, __ATOMIC_RELAXED, __HIP_MEMORY_SCOPE_AGENT); }
__device__ __forceinline__ unsigned xb_add(unsigned* p, unsigned v) { return __hip_atomic_fetch_add(p, v, __ATOMIC_RELAXED, __HIP_MEMORY_SCOPE_AGENT); }
__device__ __forceinline__ unsigned xb_xcc_id() { return (unsigned)__builtin_amdgcn_s_getreg((3 << 11) | 20) & 0xFu; }
#define XB_SPIN(cond, bar) do { unsigned _sp = 0; while (cond) { __builtin_amdgcn_s_sleep(1); \
    if ((++_sp & 255u) == 0u) { if (xb_ld(&(bar)[XB_TMO])) break; if (_sp > XB_SPIN_CAP) { atomicAdd(&(bar)[XB_TMO], 1u); break; } } } } while (0)
struct XcdBarrier { unsigned* bar; unsigned x; volatile LAS unsigned* st; };
__device__ __forceinline__ XcdBarrier xcd_barrier_post(unsigned* bar, volatile LAS unsigned* st) {
    XcdBarrier b; b.bar = bar; b.x = xb_xcc_id(); b.st = st;
    if (threadIdx.x == 0) (void)xb_add(&bar[XB_XCNT(b.x)], 1u);
    return b;
}
__device__ __forceinline__ void xcd_barrier_complete(unsigned* bar, unsigned x, unsigned& nloc, unsigned& nx) {
    const unsigned G = gridDim.x * gridDim.y * gridDim.z;
    unsigned sum, cnt, mine, sp = 0u;
    for (;;) {
        sum = 0u; cnt = 0u; mine = 0u;
#pragma unroll
        for (unsigned j = 0; j < 16; ++j) { const unsigned c = xb_ld(&bar[XB_XCNT(j)]); sum += c; cnt += (c > 0u) ? 1u : 0u; mine = (j == x) ? c : mine; }
        if (sum == G) break;
        __builtin_amdgcn_s_sleep(1);
        if ((++sp & 255u) == 0u) { if (xb_ld(&bar[XB_TMO])) break; if (sp > XB_SPIN_CAP) { atomicAdd(&bar[XB_TMO], 1u); break; } }
    }
    nloc = mine > 0u ? mine : 1u; nx = cnt > 0u ? cnt : 1u;
}
__device__ __forceinline__ void xcd_barrier(const XcdBarrier& b) {
    asm volatile("s_waitcnt vmcnt(0)" ::: "memory");
    __syncthreads();
    if (threadIdx.x == 0) {
        unsigned* bar = b.bar;
        __builtin_amdgcn_s_waitcnt(0);
        unsigned nloc = b.st[0], nx = b.st[1];
        if (nloc == 0u) { xcd_barrier_complete(bar, b.x, nloc, nx); b.st[0] = nloc; b.st[1] = nx; }
        const unsigned old = xb_add(&bar[XB_XSUB(b.x)], 1u);
        const unsigned gen = old / nloc;
        if (old + 1u == (gen + 1u) * nloc) {
            __builtin_amdgcn_fence(__ATOMIC_RELEASE, "agent");
            asm volatile("s_waitcnt vmcnt(0)" ::: "memory");
            const unsigned og = xb_add(&bar[XB_TOP], 1u);
            const unsigned tg = og / nx;
            if (og + 1u == (tg + 1u) * nx) xb_add(&bar[XB_TOPGEN], 1u);
            else XB_SPIN(xb_ld(&bar[XB_TOPGEN]) == tg, bar);
            __builtin_amdgcn_fence(__ATOMIC_ACQUIRE, "agent");
            xb_add(&bar[XB_XGEN(b.x)], 1u);
            asm volatile("s_waitcnt vmcnt(0)" ::: "memory");
        } else {
            XB_SPIN(xb_ld(&bar[XB_XGEN(b.x)]) == gen, bar);
            __builtin_amdgcn_fence(__ATOMIC_ACQUIRE, "agent");
            asm volatile("s_waitcnt vmcnt(0)" ::: "memory");
        }
    }
    __syncthreads();
}
struct Args { const float* in[19]; float* out; unsigned char* ws; int ph_lo, ph_hi; };

struct Ctx {
    const float* const* in; float* out; unsigned char* ws;
    LAS unsigned char* lds; int tid, lane, wave, G, bid;
};

__host__ __device__ __forceinline__ int wrow(int n) { return (n & ~255) | (((n >> 5) & 1) << 7) | (((n >> 6) & 3) << 5) | (n & 31); }
__device__ __forceinline__ void tr_item(const float* W, int K, int N, bf16_t* WT, const float* gs, LAS float* scr, int item, int lane) {
    const int nblk = N / 32, kb = item / nblk, nb = item % nblk, k0 = 64 * kb, n0 = 32 * nb;
    const int c4 = (lane & 7) * 4;
#pragma unroll
    for (int i = 0; i < 8; ++i) { const int kk = 8 * i + (lane >> 3); const float s = gs ? gs[k0 + kk] : 1.f; const f32x4 v = *(const f32x4*)(W + (size_t)(k0 + kk) * N + n0 + c4) * s;
        LAS float* d = scr + kk * 33 + c4; d[0] = v[0]; d[1] = v[1]; d[2] = v[2]; d[3] = v[3]; }
    asm volatile("s_waitcnt lgkmcnt(0)" ::: "memory");
    const int c = lane & 7;
#pragma unroll
    for (int j = 0; j < 4; ++j) { const int n = (lane >> 3) + 8 * j; const LAS float* s = scr + (8 * c) * 33 + n;
        u32x4 o; o.x = pk2(s[0 * 33], s[1 * 33]); o.y = pk2(s[2 * 33], s[3 * 33]); o.z = pk2(s[4 * 33], s[5 * 33]); o.w = pk2(s[6 * 33], s[7 * 33]);
        *(u32x4*)(WT + (size_t)wrow(n0 + n) * K + k0 + 8 * c) = o; }
    asm volatile("s_waitcnt lgkmcnt(0)" ::: "memory");
}

__device__ __forceinline__ void prologue(const Ctx& C) {
    const int gw = C.bid * 8 + C.wave, NGW = C.G * 8; const int gt = C.bid * 512 + C.tid, NGT = C.G * 512;
    { u64* s = (u64*)(C.ws + WS_SSQ) + M; for (int i = gt; i < 4 * M; i += NGT) s[i] = 0ull;
      unsigned* ctr = (unsigned*)(C.ws + WS_CTR); if (gt < 64) ctr[gt] = 0u;
      unsigned* barw = (unsigned*)(C.ws + WS_BAR); if (gt < 3456) barw[gt] = 0u;
      for (int l = 0; l < 2; ++l) { bf16_t* wt = (bf16_t*)(C.ws + WS_W + l * W_LAYER + WO_IN); for (int i = gt; i < (INP - INC) * DM / 8; i += NGT) { const int n = INC + i / (DM / 8), ch = i % (DM / 8); *(u32x4*)(wt + (size_t)wrow(n) * DM + ch * 8) = (u32x4){0u, 0u, 0u, 0u}; } } }
    { bf16_t* wtg = (bf16_t*)(C.ws + WS_WTG);
      for (int i = gt; i < 2 * 6 * 2 * 4096; i += NGT) { const int o = i & 63, k = (i >> 6) & 63, mat = (i >> 12) & 1, lh = i >> 13;
          const float v = (mat ? gptr(C.in[11]) : gptr(C.in[9]))[(size_t)lh * 4096 + k * 64 + o]; wtg[((size_t)(lh * 2 + mat) * 64 + o) * 64 + k] = (bf16_t)f2bf(v); } }
    LAS float* scr = (LAS float*)(C.lds + C.wave * 16384);
    constexpr int I_IN = (DM / 64) * (INC / 32), I_OUT = (DM / 64) * (DM / 32), I_UP = (DM / 64) * (FF / 32), I_DN = (FF / 64) * (DM / 32), I_L = I_IN + I_OUT + I_UP + I_DN;
    for (int it = gw; it < 2 * I_L; it += NGW) {
        const int l = it / I_L; int r = it % I_L; unsigned char* wb = C.ws + WS_W + l * W_LAYER;
        if (r < I_IN) { tr_item(gptr(C.in[2]) + (size_t)l * DM * INC, DM, INC, (bf16_t*)(wb + WO_IN), gptr(C.in[1]) + l * DM, scr, r, C.lane); continue; } r -= I_IN;
        if (r < I_OUT) { tr_item(gptr(C.in[14]) + (size_t)l * DM * DM, DM, DM, (bf16_t*)(wb + WO_OUT), nullptr, scr, r, C.lane); continue; } r -= I_OUT;
        if (r < I_UP) { tr_item(gptr(C.in[16]) + (size_t)l * DM * FF, DM, FF, (bf16_t*)(wb + WO_UP), gptr(C.in[15]) + l * DM, scr, r, C.lane); continue; } r -= I_UP;
        tr_item(gptr(C.in[17]) + (size_t)l * FF * DM, FF, DM, (bf16_t*)(wb + WO_DN), nullptr, scr, r, C.lane);
    }
    const float* x = gptr(C.in[0]); bf16_t* xb = (bf16_t*)(C.ws + WS_XB); u64* ssq0 = (u64*)(C.ws + WS_SSQ);
    for (int m0 = gw * 4; m0 < M; m0 += NGW * 4) {
        f32x4 v[4][4]; float sq[4];
#pragma unroll
        for (int r = 0; r < 4; ++r) { const f32x4* xr = (const f32x4*)(x + (size_t)(m0 + r) * DM) + 2 * C.lane;
#pragma unroll
            for (int j = 0; j < 2; ++j) { v[r][2 * j] = xr[128 * j]; v[r][2 * j + 1] = xr[128 * j + 1]; } }
#pragma unroll
        for (int r = 0; r < 4; ++r) { float s = 0.f;
#pragma unroll
            for (int j = 0; j < 4; ++j) s += (v[r][j].x * v[r][j].x + v[r][j].y * v[r][j].y) + (v[r][j].z * v[r][j].z + v[r][j].w * v[r][j].w);
            sq[r] = wave_sum(s); }
#pragma unroll
        for (int r = 0; r < 4; ++r) {
            if (C.lane == 0) ssq0[m0 + r] = (u64)(sq[r] * 16777216.0f);
            u32x4* o16 = (u32x4*)(xb + (size_t)(m0 + r) * DM) + C.lane;
#pragma unroll
            for (int j = 0; j < 2; ++j) { u32x4 w; w.x = pk2(v[r][2 * j].x, v[r][2 * j].y); w.y = pk2(v[r][2 * j].z, v[r][2 * j].w); w.z = pk2(v[r][2 * j + 1].x, v[r][2 * j + 1].y); w.w = pk2(v[r][2 * j + 1].z, v[r][2 * j + 1].w); o16[64 * j] = w; } }
    }
}

struct MixCtx { const bf16_t* Z; bf16_t* MIX; bf16_t* AO; float* LSE; bf16_t* Y2; float* SUM; const bf16_t* WTG; const float* const* in; int l; };
__device__ __forceinline__ MixCtx mk_mix(unsigned char* ws, const float* const* in, int l) { ws = launder(ws); asm volatile("" : "+s"(l));
    MixCtx X; X.Z = (const bf16_t*)(ws + WS_Z); X.MIX = (bf16_t*)(ws + WS_MIX); X.AO = (bf16_t*)(ws + WS_AO); X.LSE = (float*)(ws + WS_LSE); X.Y2 = (bf16_t*)(ws + WS_Y2); X.SUM = (float*)(ws + WS_SUM); X.WTG = (const bf16_t*)(ws + WS_WTG); X.in = in; X.l = l; return X; }

struct AttnPre { u32x4 k[4], v[4]; bf16x8 q0, q1; };
__device__ __forceinline__ void attn_load(const bf16_t* Z, int a, int tid, AttnPre& P) {
    const int lane = tid & 63, w = tid >> 6;
    const int b = a / 96, rem = a % 96, h = rem >> 4, u16 = rem & 15;
    const int sh = 2 * (h >> 1), dil = 1 << sh, nbm = (16 >> sh) - 1;
    const int r = u16 >> (4 - sh), n = u16 & nbm;
    const bf16_t* zb = Z + (size_t)b * SEQ * INC;
#pragma unroll
    for (int i = 0; i < 4; ++i) { const int c = tid + 512 * i; const int row = c >> 3, ch = c & 7; const int sub = (n - 1) * 128 + row;
        P.k[i] = (u32x4){0u, 0u, 0u, 0u}; P.v[i] = (u32x4){0u, 0u, 0u, 0u};
        if (sub >= 0) { const size_t off = (size_t)(sub * dil + r) * INC + h * 64 + ch * 8; P.k[i] = *(const u32x4*)(zb + off + K0); P.v[i] = *(const u32x4*)(zb + off + V0); } }
    const int j = lane & 15, kq = lane >> 4; const int qi = 16 * w + j; const int qpos = (n * 128 + qi) * dil + r;
    const bf16_t* qp = zb + (size_t)qpos * INC + Q0 + h * 64 + kq * 8;
    P.q0 = *(const bf16x8*)qp; P.q1 = *(const bf16x8*)(qp + 32);
}
__device__ __forceinline__ void attn_compute(const MixCtx& X, int a, LAS unsigned char* lds, int tid, const bf16x8 q0, const bf16x8 q1) {
    const int lane = tid & 63, w = __builtin_amdgcn_readfirstlane(tid >> 6);
    const int b = a / 96, rem = a % 96, h = rem >> 4, u16 = rem & 15;
    const int sh = 2 * (h >> 1), dil = 1 << sh, nbm = (16 >> sh) - 1;
    const int r = u16 >> (4 - sh), n = u16 & nbm;
    const float slope = exp2f(-8.0f * (float)(h + 1) / 6.0f);
    const float c1 = 0.125f * LOG2E, c2 = slope * (float)dil * LOG2E;
    LAS unsigned char* Kl = lds; LAS unsigned char* Vl = lds + 39168;
    const int j = lane & 15, kq = lane >> 4;
    const int qi = 16 * w + j; const int qpos = (n * 128 + qi) * dil + r;
    float s[9][4]; float mx = -1e30f;
    const int d0 = j + 128 - 4 * kq;
    float be[4]; const float bstep = 16.0f * c2;
#pragma unroll
    for (int e = 0; e < 4; ++e) be[e] = -c2 * (float)(d0 - e);
    const int nlive0 = (n == 0) ? (8 - w) : 0;
#pragma unroll
    for (int tt = 0; tt < 9; ++tt) {
        if (tt >= nlive0) {
            const int kt = w + tt; const LAS unsigned char* p = Kl + (16 * kt + j) * 144 + kq * 16;
            const bf16x8 k0f = *(const LAS bf16x8*)p, k1f = *(const LAS bf16x8*)(p + 64);
            f32x4 acc = (f32x4){0.f, 0.f, 0.f, 0.f};
            acc = __builtin_amdgcn_mfma_f32_16x16x32_bf16(k0f, q0, acc, 0, 0, 0);
            acc = __builtin_amdgcn_mfma_f32_16x16x32_bf16(k1f, q1, acc, 0, 0, 0);
#pragma unroll
            for (int e = 0; e < 4; ++e) {
                float v = acc[e] * c1 + (be[e] + bstep * (float)tt);
                if (tt == 0) { if (d0 - e > 128) v = -1e30f; }
                if (tt == 8) { if (d0 - 128 - e < 0) v = -1e30f; }
                s[tt][e] = v; mx = fmaxf(mx, v); }
        } else {
#pragma unroll
            for (int e = 0; e < 4; ++e) s[tt][e] = -1e30f;
        }
    }
    mx = fmaxf(mx, __shfl_xor(mx, 16)); mx = fmaxf(mx, __shfl_xor(mx, 32));
    float l = 0.f;
#pragma unroll
    for (int tt = 0; tt < 9; ++tt) {
        if (tt >= nlive0) {
#pragma unroll
            for (int e = 0; e < 4; ++e) { const float pv = __builtin_amdgcn_exp2f(s[tt][e] - mx); s[tt][e] = pv; l += pv; }
        } else {
#pragma unroll
            for (int e = 0; e < 4; ++e) s[tt][e] = 0.f;
        }
    }
    l += __shfl_xor(l, 16); l += __shfl_xor(l, 32);
    f32x4 o[4];
#pragma unroll
    for (int dt = 0; dt < 4; ++dt) o[dt] = (f32x4){0.f, 0.f, 0.f, 0.f};
    const int qq = (lane & 15) >> 2, pp = lane & 3;
#pragma unroll
    for (int c = 0; c < 5; ++c) {
        if (2 * c + 1 >= nlive0) {
            u32x4 pw; pw.x = cvt_pk_bf16(s[2 * c][0], s[2 * c][1]); pw.y = cvt_pk_bf16(s[2 * c][2], s[2 * c][3]);
            if (c < 4) { pw.z = cvt_pk_bf16(s[2 * c + 1][0], s[2 * c + 1][1]); pw.w = cvt_pk_bf16(s[2 * c + 1][2], s[2 * c + 1][3]); } else { pw.z = 0u; pw.w = 0u; }
            const bf16x8 pb = __builtin_bit_cast(bf16x8, pw);
            const int row = 16 * (w + 2 * c) + 4 * kq + qq;
#pragma unroll
            for (int dt = 0; dt < 4; ++dt) {
                LAS unsigned char* vp = Vl + row * 160 + (16 * dt + 4 * pp) * 2;
                const v4i16_t lo = __builtin_amdgcn_ds_read_tr16_b64_v4i16((LAS v4i16_t*)vp);
                const v4i16_t hi = __builtin_amdgcn_ds_read_tr16_b64_v4i16((LAS v4i16_t*)(vp + 16 * 160));
                const bf16x8 vf = (bf16x8){lo[0], lo[1], lo[2], lo[3], hi[0], hi[1], hi[2], hi[3]};
                o[dt] = __builtin_amdgcn_mfma_f32_16x16x32_bf16(vf, pb, o[dt], 0, 0, 0);
            }
        }
    }
    const float inv = 1.0f / l;
    LAS unsigned char* so = lds + 82944 + w * 2304;
#pragma unroll
    for (int dt = 0; dt < 4; ++dt) { u32x2 wv; wv.x = cvt_pk_bf16(o[dt][0] * inv, o[dt][1] * inv); wv.y = cvt_pk_bf16(o[dt][2] * inv, o[dt][3] * inv); *(LAS u32x2*)(so + j * 144 + (16 * dt + 4 * kq) * 2) = wv; }
#pragma unroll
    for (int i = 0; i < 2; ++i) { const int rq = (lane >> 3) + 8 * i, cq = lane & 7; const int qpr = (n * 128 + 16 * w + rq) * dil + r;
        const u32x4 qv = *(const LAS u32x4*)(so + rq * 144 + cq * 16);
        *(u32x4*)(X.AO + ((size_t)b * SEQ + qpr) * AW + h * 64 + cq * 8) = qv; }
    if (kq == 0) X.LSE[((size_t)b * SEQ + qpos) * 6 + h] = (mx + __log2f(l)) * LN2;
}
__device__ __forceinline__ void attn_loop(unsigned char* ws_, const float* const* in_, int l_, LAS unsigned char* lds, int tid, int a_start, int a_cnt, int a_stride) {
    const MixCtx X = mk_mix(ws_, in_, l_); tid = launder_v(tid);
    LAS unsigned char* Kl = lds; LAS unsigned char* Vl = lds + 39168;
    if (tid < 128) { const int row = 256 + (tid >> 3), ch = tid & 7; const unsigned z = (unsigned)launder_v(0); const u32x4 zz = (u32x4){z, z, z, z}; *(LAS u32x4*)(Kl + row * 144 + ch * 16) = zz; *(LAS u32x4*)(Vl + row * 160 + ch * 16) = zz; }
    AttnPre P; int a = a_start;
    if (a_cnt > 0) attn_load(X.Z, a, tid, P);
    for (int k = 0; k < a_cnt; ++k, a += a_stride) {
        __syncthreads();
#pragma unroll
        for (int i = 0; i < 4; ++i) { const int c = tid + 512 * i; const int row = c >> 3, ch = c & 7;
            *(LAS u32x4*)(Kl + row * 144 + ch * 16) = P.k[i]; *(LAS u32x4*)(Vl + row * 160 + ch * 16) = P.v[i]; }
        const bf16x8 q0 = P.q0, q1 = P.q1;
        __syncthreads();
        if (k + 1 < a_cnt) attn_load(X.Z, a + a_stride, tid, P);
        attn_compute(X, a, lds, tid, q0, q1);
    }
    __syncthreads();
}

__device__ __forceinline__ void conv_glu8(const u32x4 av, const u32x4 gv, f32x4& u0, f32x4& u1) {
    u0[0] = bf_lo(av.x) * sigmoidf_(bf_lo(gv.x)); u0[1] = bf_hi(av.x) * sigmoidf_(bf_hi(gv.x)); u0[2] = bf_lo(av.y) * sigmoidf_(bf_lo(gv.y)); u0[3] = bf_hi(av.y) * sigmoidf_(bf_hi(gv.y));
    u1[0] = bf_lo(av.z) * sigmoidf_(bf_lo(gv.z)); u1[1] = bf_hi(av.z) * sigmoidf_(bf_hi(gv.z)); u1[2] = bf_lo(av.w) * sigmoidf_(bf_lo(gv.w)); u1[3] = bf_hi(av.w) * sigmoidf_(bf_hi(gv.w));
}
__device__ __forceinline__ int ring94(int r) { return r >= 94 ? r - 94 : r; }
template <int S> struct ConvStep {
    static __device__ __forceinline__ void run(float (&acc)[32], const float (&wv)[31], const LAS float* U, int rb, int cch) {
        const float uv = U[ring94(ring94(rb + S)) * 256 + cch];
#pragma unroll
        for (int o = 0; o < 32; ++o) { constexpr int dummy = 0; const int kk = S - o + dummy; if (kk >= 0 && kk <= 30) acc[o] += wv[kk] * uv; }
        ConvStep<S + 1>::run(acc, wv, U, rb, cch);
    }
};
template <> struct ConvStep<62> { static __device__ __forceinline__ void run(float (&)[32], const float (&)[31], const LAS float*, int, int) {} };
__device__ __forceinline__ void conv_loop(unsigned char* ws_, const float* const* in_, int l_, LAS unsigned char* lds, int tid, int bid, int G) {
    const MixCtx X = mk_mix(ws_, in_, l_); tid = launder_v(tid);
    const int lane = tid & 63, w = tid >> 6;
    LAS float* U = (LAS float*)lds;
    const int cch = tid & 255, half = tid >> 8;
    const float* cw = gptr(X.in[3]) + (size_t)X.l * 31 * CW; float wv[31]; int cwo = cch;
#pragma unroll
    for (int k = 0; k < 31; ++k) { wv[k] = cw[cwo]; cwo += CW; asm volatile("" : "+v"(cwo)); }
    const float bias = gptr(X.in[4])[X.l * CW + cch];
    const f32x4 gg = *(const f32x4*)(gptr(X.in[5]) + X.l * CW + 4 * lane), bb = *(const f32x4*)(gptr(X.in[6]) + X.l * CW + 4 * lane);
    for (int cc = bid; cc < BATCH * 8; cc += G) {
        const int b = cc >> 3, tb = (cc & 7) * 4;
        const bf16_t* zb = X.Z + (size_t)b * SEQ * INC;
        u32x4 pa[4], pg[4];
#pragma unroll
        for (int i = 0; i < 4; ++i) { const int idx = tid + 512 * i; const int row = idx >> 5, ch = idx & 31; const size_t t = (size_t)(tb * 64 + row);
            pa[i] = *(const u32x4*)(zb + t * INC + CA0 + ch * 8); pg[i] = *(const u32x4*)(zb + t * INC + CG0 + ch * 8); }
        __syncthreads();
#pragma unroll
        for (int i = 0; i < 2; ++i) { const int idx = tid + 512 * i; if (idx < 30 * 32) { const int row = idx >> 5, ch = idx & 31; const int t = tb * 64 - 30 + row;
            f32x4 u0 = (f32x4){0.f, 0.f, 0.f, 0.f}, u1 = u0;
            if (t >= 0) { const u32x4 av = *(const u32x4*)(zb + (size_t)t * INC + CA0 + ch * 8), gv = *(const u32x4*)(zb + (size_t)t * INC + CG0 + ch * 8); conv_glu8(av, gv, u0, u1); }
            *(LAS f32x4*)(U + row * 256 + ch * 8) = u0; *(LAS f32x4*)(U + row * 256 + ch * 8 + 4) = u1; } }
        int base = 0;
        for (int k = 0; k < 4; ++k) {
            const int t0 = (tb + k) * 64;
#pragma unroll
            for (int i = 0; i < 4; ++i) { const int idx = tid + 512 * i; const int row = ring94(base + 30 + (idx >> 5)), ch = idx & 31; f32x4 u0, u1; conv_glu8(pa[i], pg[i], u0, u1);
                *(LAS f32x4*)(U + row * 256 + ch * 8) = u0; *(LAS f32x4*)(U + row * 256 + ch * 8 + 4) = u1; }
            __syncthreads();
            if (k < 3) {
#pragma unroll
                for (int i = 0; i < 4; ++i) { const int idx = tid + 512 * i; const int row = idx >> 5, ch = idx & 31; const size_t t = (size_t)(t0 + 64 + row);
                    pa[i] = *(const u32x4*)(zb + t * INC + CA0 + ch * 8); pg[i] = *(const u32x4*)(zb + t * INC + CG0 + ch * 8); }
            }
            float acc[32];
#pragma unroll
            for (int o = 0; o < 32; ++o) acc[o] = bias;
            const int rb = base + 32 * half;
            ConvStep<0>::run(acc, wv, U, rb, cch);
            __syncthreads();
#pragma unroll
            for (int o = 0; o < 32; ++o) U[ring94(ring94(rb + o)) * 256 + cch] = acc[o];
            __syncthreads();
#pragma unroll
            for (int i = 0; i < 8; ++i) { const int tok = 8 * w + i; f32x4 v = *(LAS f32x4*)(U + ring94(base + tok) * 256 + 4 * lane);
                const float mean = wave_sum((v[0] + v[1]) + (v[2] + v[3])) * (1.0f / 256.0f);
                v = v - mean; const float var = wave_sum((v[0] * v[0] + v[1] * v[1]) + (v[2] * v[2] + v[3] * v[3])) * (1.0f / 256.0f);
                const float rstd = rsqrtf(var + LN_EPS); f32x4 y = v * rstd * gg + bb;
#pragma unroll
                for (int e = 0; e < 4; ++e) y[e] = y[e] * sigmoidf_(y[e]);
                u32x2 wv2; wv2.x = cvt_pk_bf16(y[0], y[1]); wv2.y = cvt_pk_bf16(y[2], y[3]);
                *(u32x2*)(X.MIX + ((size_t)b * SEQ + t0 + tok) * DM + AW + 4 * lane) = wv2; }
            __syncthreads();
            base = ring94(base + 64);
        }
    }
}

constexpr int LR_UB = 0, LR_A = 18432, LR_B = 53248, LR_WT = 88064, LR_PRM = 106496, LR_SA = 107264, LR_SB = 109312, LR_GT = 111360, LR_CAR = 129792;
__device__ __forceinline__ float gelu_tanh(float x) { const float y = 0.7978845608028654f * (x + 0.044715f * x * x * x); const float e = __expf(2.f * y); return 0.5f * x * (2.f - 2.f * __builtin_amdgcn_rcpf(1.f + e)); }
struct LruPre { u32x4 x[5], g[2]; };
__device__ __forceinline__ void lru_load(const MixCtx& X, int b, int h, int chunk, int tid, LruPre& P) {
    const int c0 = h * 64, t0 = chunk * 128;
    const bf16_t* zb = X.Z + (size_t)b * SEQ * INC; const int cg8 = tid & 7, tp = tid >> 3;
#pragma unroll
    for (int rr = 0; rr < 5; ++rr) { const int t = t0 + 2 * tp - 3 + rr; P.x[rr] = (u32x4){0u, 0u, 0u, 0u}; if (t >= 0) P.x[rr] = *(const u32x4*)(zb + (size_t)t * INC + LX0 + c0 + 8 * cg8); }
#pragma unroll
    for (int i = 0; i < 2; ++i) { const int idx = tid + 512 * i; const int row = idx >> 3, ch = idx & 7;
        P.g[i] = *(const u32x4*)(zb + (size_t)(t0 + row) * INC + LG0 + c0 + ch * 8); }
}
__device__ __forceinline__ void lru_chain(unsigned char* ws_, const float* const* in_, int l_, LAS unsigned char* lds, int tid, int bid, int G) {
    const MixCtx X = mk_mix(ws_, in_, l_); tid = launder_v(tid);
    const int lane = tid & 63, w = __builtin_amdgcn_readfirstlane(tid >> 6); const int l = X.l;
    LAS unsigned char* UB = lds + LR_UB; LAS float* A_ = (LAS float*)(lds + LR_A); LAS float* B_ = (LAS float*)(lds + LR_B);
    LAS unsigned char* WT = lds + LR_WT; LAS float* PRM = (LAS float*)(lds + LR_PRM); LAS float* SA = (LAS float*)(lds + LR_SA); LAS float* SB = (LAS float*)(lds + LR_SB); LAS unsigned char* GT = lds + LR_GT;
    LAS float* CAR = (LAS float*)(lds + LR_CAR);
    const int cg8 = tid & 7, tp = tid >> 3; const int j = lane & 15, kq = lane >> 4;
    for (int chain = bid; chain < BATCH * 6; chain += G) {
        const int b = chain / 6, h = chain % 6, c0 = h * 64;
        LruPre P; lru_load(X, b, h, 0, tid, P);
        f32x4 cwv[4][2], cbv[2];
#pragma unroll
        for (int e2 = 0; e2 < 2; ++e2) { cbv[e2] = *(const f32x4*)(gptr(X.in[8]) + l * LW + c0 + 8 * cg8 + 4 * e2);
#pragma unroll
            for (int k = 0; k < 4; ++k) cwv[k][e2] = *(const f32x4*)(gptr(X.in[7]) + (size_t)(l * 4 + k) * LW + c0 + 8 * cg8 + 4 * e2); }
        __syncthreads();
#pragma unroll
        for (int i = 0; i < 2; ++i) { const int idx = tid + 512 * i; const int row = idx >> 3, ch = idx & 7;
            *(LAS u32x4*)(WT + row * 144 + ch * 16) = *(const u32x4*)(X.WTG + (size_t)(l * 6 + h) * 8192 + idx * 8); }
        if (tid < 64) { PRM[tid] = gptr(X.in[10])[l * LW + c0 + tid]; PRM[64 + tid] = gptr(X.in[12])[l * LW + c0 + tid]; PRM[128 + tid] = log1pf(__expf(-gptr(X.in[13])[l * LW + c0 + tid])); CAR[tid] = 0.f; }
        LAS unsigned char* OT = lds + LR_A;
        for (int chunk = 0; chunk < 16; ++chunk) {
            const int t0 = chunk * 128;
            if (chunk > 0) {
#pragma unroll
                for (int i = 0; i < 2; ++i) { const int idx = tid + 512 * i; const int row = idx >> 3, ch = idx & 7;
                    *(u32x4*)(X.MIX + ((size_t)b * SEQ + t0 - 128 + row) * DM + AW + CW + c0 + ch * 8) = *(const LAS u32x4*)(OT + row * 144 + ch * 16); }
            }
#pragma unroll
            for (int i = 0; i < 2; ++i) { const int idx = tid + 512 * i; const int row = idx >> 3, ch = idx & 7; *(LAS u32x4*)(GT + row * 144 + ch * 16) = P.g[i]; }
            { f32x4 xv[5][2];
#pragma unroll
              for (int rr = 0; rr < 5; ++rr) { const u32x4 v = P.x[rr]; xv[rr][0] = (f32x4){bf_lo(v.x), bf_hi(v.x), bf_lo(v.y), bf_hi(v.y)}; xv[rr][1] = (f32x4){bf_lo(v.z), bf_hi(v.z), bf_lo(v.w), bf_hi(v.w)}; }
#pragma unroll
              for (int tk = 0; tk < 2; ++tk) { f32x4 u0 = cbv[0], u1 = cbv[1];
#pragma unroll
                  for (int k = 0; k < 4; ++k) { u0 += cwv[k][0] * xv[tk + k][0]; u1 += cwv[k][1] * xv[tk + k][1]; }
                  const int tok = 2 * tp + tk;
                  u32x4 pw; pw.x = cvt_pk_bf16(u0[0], u0[1]); pw.y = cvt_pk_bf16(u0[2], u0[3]); pw.z = cvt_pk_bf16(u1[0], u1[1]); pw.w = cvt_pk_bf16(u1[2], u1[3]);
                  *(LAS u32x4*)(UB + tok * 144 + cg8 * 16) = pw;
                  *(LAS f32x4*)(B_ + tok * 68 + cg8 * 8) = u0; *(LAS f32x4*)(B_ + tok * 68 + cg8 * 8 + 4) = u1; } }
            __syncthreads();
            if (chunk < 15) lru_load(X, b, h, chunk + 1, tid, P);
            { const int tok = 16 * w + j; bf16x8 bfr[2];
#pragma unroll
              for (int c = 0; c < 2; ++c) bfr[c] = *(const LAS bf16x8*)(UB + tok * 144 + kq * 16 + c * 64);
#pragma unroll
              for (int ot = 0; ot < 4; ++ot) { f32x4 da = (f32x4){0.f, 0.f, 0.f, 0.f}, dx = da;
#pragma unroll
                  for (int c = 0; c < 2; ++c) { const bf16x8 fa = *(const LAS bf16x8*)(WT + (16 * ot + j) * 144 + kq * 16 + c * 64), fx = *(const LAS bf16x8*)(WT + (64 + 16 * ot + j) * 144 + kq * 16 + c * 64);
                      da = __builtin_amdgcn_mfma_f32_16x16x32_bf16(fa, bfr[c], da, 0, 0, 0); dx = __builtin_amdgcn_mfma_f32_16x16x32_bf16(fx, bfr[c], dx, 0, 0, 0); }
                  const int ch = 16 * ot + 4 * kq;
                  const f32x4 ba4 = *(const LAS f32x4*)(PRM + ch), bx4 = *(const LAS f32x4*)(PRM + 64 + ch), sp4 = *(const LAS f32x4*)(PRM + 128 + ch);
                  const f32x4 u4 = *(const LAS f32x4*)(B_ + tok * 68 + ch); f32x4 a4, b4;
#pragma unroll
                  for (int e = 0; e < 4; ++e) { const float rg = sigmoidf_(da[e] + ba4[e]), ig = sigmoidf_(dx[e] + bx4[e]); const float la = -8.0f * rg * sp4[e];
                      const float av_ = __expf(la); a4[e] = av_; b4[e] = sqrtf(fmaxf(1.0f - av_ * av_, 0.f)) * ig * u4[e]; }
                  *(LAS f32x4*)(A_ + tok * 68 + ch) = a4; *(LAS f32x4*)(B_ + tok * 68 + ch) = b4; } }
            __syncthreads();
            float av[16], bv[16]; float hh = 0.f, aa = 1.f;
#pragma unroll
            for (int i = 0; i < 16; ++i) { av[i] = A_[(16 * w + i) * 68 + lane]; bv[i] = B_[(16 * w + i) * 68 + lane]; hh = av[i] * hh + bv[i]; aa *= av[i]; }
            SA[w * 64 + lane] = aa; SB[w * 64 + lane] = hh;
            __syncthreads();
            float hin = CAR[(chunk & 1) * 64 + lane];
            for (int sgi = 0; sgi < w; ++sgi) hin = SA[sgi * 64 + lane] * hin + SB[sgi * 64 + lane];
            hh = hin;
#pragma unroll
            for (int i = 0; i < 16; i += 2) { hh = av[i] * hh + bv[i]; const float h0 = hh; hh = av[i + 1] * hh + bv[i + 1]; const int tl = 16 * w + i;
                const float g0 = gelu_tanh(bf2f(*(const LAS bf16_t*)(GT + tl * 144 + lane * 2))), g1 = gelu_tanh(bf2f(*(const LAS bf16_t*)(GT + (tl + 1) * 144 + lane * 2)));
                const unsigned pk = cvt_pk_bf16(g0 * h0, g1 * hh);
                *(LAS bf16_t*)(OT + tl * 144 + lane * 2) = (bf16_t)(pk & 0xffffu); *(LAS bf16_t*)(OT + (tl + 1) * 144 + lane * 2) = (bf16_t)(pk >> 16); }
            if (w == 7) CAR[((chunk + 1) & 1) * 64 + lane] = hh;
            __syncthreads();
        }
#pragma unroll
        for (int i = 0; i < 2; ++i) { const int idx = tid + 512 * i; const int row = idx >> 3, ch = idx & 7;
            *(u32x4*)(X.MIX + ((size_t)b * SEQ + 15 * 128 + row) * DM + AW + CW + c0 + ch * 8) = *(const LAS u32x4*)(OT + row * 144 + ch * 16); }
    }
}

__device__ __forceinline__ void mixer_phase(const Ctx& C, int l) {
    lru_chain(C.ws, C.in, l, C.lds, C.tid, C.bid, C.G);
    int a_start, a_cnt, a_stride;
    if (C.G == 256) { if (C.bid >= 192) { a_start = (C.bid - 192) * 27; a_cnt = 27; } else { a_start = 64 * 27 + C.bid * 7; a_cnt = 7; } a_stride = 1; }
    else { a_start = C.bid; a_stride = C.G; a_cnt = (N_ATT - C.bid + C.G - 1) / C.G; }
    attn_loop(C.ws, C.in, l, C.lds, C.tid, a_start, a_cnt, a_stride);
    conv_loop(C.ws, C.in, l, C.lds, C.tid, C.bid, C.G);
}

__device__ __forceinline__ void alpha_phase(const Ctx& C) {
    const bf16_t* AO = (const bf16_t*)(C.ws + WS_AO); bf16_t* MIX = (bf16_t*)(C.ws + WS_MIX); const float* LSE = (const float*)(C.ws + WS_LSE);
    const int gw = C.bid * 8 + C.wave, NGW = C.G * 8;
    for (int tg = gw; tg < M / 4; tg += NGW) {
#pragma unroll
        for (int i = 0; i < 3; ++i) { const int L = C.lane + 64 * i; const size_t tok = (size_t)4 * tg + L / 48; const int ch = L % 48, h = ch >> 3, jj = h & 1, g = h >> 1;
            const float l0 = LSE[tok * 6 + jj], l1 = LSE[tok * 6 + 2 + jj], l2 = LSE[tok * 6 + 4 + jj];
            const float mx = fmaxf(l0, fmaxf(l1, l2)); const float e0 = __expf(l0 - mx), e1 = __expf(l1 - mx), e2 = __expf(l2 - mx);
            const float al = (g == 0 ? e0 : (g == 1 ? e1 : e2)) / (e0 + e1 + e2);
            const u32x4 v = *(const u32x4*)(AO + tok * AW + ch * 8); u32x4 o;
            o.x = pk2(bf_lo(v.x) * al, bf_hi(v.x) * al); o.y = pk2(bf_lo(v.y) * al, bf_hi(v.y) * al); o.z = pk2(bf_lo(v.z) * al, bf_hi(v.z) * al); o.w = pk2(bf_lo(v.w) * al, bf_hi(v.w) * al);
            *(u32x4*)(MIX + tok * DM + ch * 8) = o; }
    }
}

__device__ __forceinline__ void final_phase(const Ctx& C) {
    const u64* ssq = (const u64*)(C.ws + WS_SSQ) + 4 * (size_t)M; const float* g = gptr(C.in[18]);
    const int gw = C.bid * 8 + C.wave, NGW = C.G * 8;
    f32x4 gv[4];
#pragma unroll
    for (int j = 0; j < 2; ++j) { gv[2 * j] = *((const f32x4*)g + 2 * C.lane + 128 * j); gv[2 * j + 1] = *((const f32x4*)g + 2 * C.lane + 128 * j + 1); }
    const bf16_t* XB = (const bf16_t*)(C.ws + WS_XB);
    for (int m0 = gw * 4; m0 < M; m0 += NGW * 4) {
        u32x4 v[4][2]; float ri[4];
#pragma unroll
        for (int r = 0; r < 4; ++r) { ri[r] = rinv_from(__hip_atomic_load(ssq + m0 + r, __ATOMIC_RELAXED, __HIP_MEMORY_SCOPE_AGENT)); const u32x4* xi = (const u32x4*)(XB + (size_t)(m0 + r) * DM) + C.lane;
#pragma unroll
            for (int j = 0; j < 2; ++j) v[r][j] = xi[64 * j]; }
#pragma unroll
        for (int r = 0; r < 4; ++r) { f32x4* xr = (f32x4*)(C.out + (size_t)(m0 + r) * DM) + 2 * C.lane;
#pragma unroll
            for (int j = 0; j < 2; ++j) { const u32x4 q = v[r][j];
                xr[128 * j] = (f32x4){bf_lo(q.x), bf_hi(q.x), bf_lo(q.y), bf_hi(q.y)} * ri[r] * gv[2 * j];
                xr[128 * j + 1] = (f32x4){bf_lo(q.z), bf_hi(q.z), bf_lo(q.w), bf_hi(q.w)} * ri[r] * gv[2 * j + 1]; } }
    }
}

constexpr int N_PHASES = 14;
__global__ void __launch_bounds__(512, 2) fwd_kernel(Args args) {
    extern __shared__ __attribute__((aligned(16))) unsigned char lds_raw[];
#define IN(k) (true)
#define MKCTX Ctx C; C.in = args.in; C.out = (float*)launder((unsigned char*)args.out); C.ws = launder(args.ws); C.lds = (LAS unsigned char*)lds_raw; \
    C.tid = launder_v((int)threadIdx.x); C.lane = C.tid & 63; C.wave = __builtin_amdgcn_readfirstlane(C.tid >> 6); C.G = gridDim.x; C.bid = blockIdx.x;
    LAS unsigned char* const ldsp = (LAS unsigned char*)lds_raw; const int G_ = gridDim.x, bid_ = blockIdx.x;
#define SYNC(k) do { xcd_barrier(xbar); } while (0)
    { volatile LAS unsigned* misc = (volatile LAS unsigned*)(lds_raw + MISC_OFF); if (threadIdx.x < 16) misc[threadIdx.x] = 0u; __syncthreads(); }
    if (IN(0)) { MKCTX; prologue(C); }
    cg::this_grid().sync();
    XcdBarrier xbar = xcd_barrier_post((unsigned*)(args.ws + WS_BAR), (volatile LAS unsigned*)((LAS unsigned char*)lds_raw + MISC_OFF + 32));
    for (int l = 0; l < 2; ++l) {
        asm volatile("" : "+s"(l));
        const int pb = 1 + 6 * l;
        if (IN(pb)) {
            unsigned char* ws = launder(args.ws); unsigned char* wb = ws + WS_W + l * W_LAYER;
            pg8::Gemm g{(const bf16_t*)(ws + WS_XB), (const bf16_t*)(wb + WO_IN), M, INP, DM}; pg8::StaticOrder S; S.init(M, INP, G_, bid_);
            pg8::EpiRowScale<0> E{(bf16_t*)(ws + WS_Z), INC, (const u64*)(ws + WS_SSQ) + (size_t)(2 * l) * M, INC, ldsp + EPI_STG_OFF};
            pg8::gemm_phase<pg8::EpiRowScale<0>, pg8::StaticOrder, true, true>(ldsp, g, S, E);
        }
        SYNC(pb);
        if (IN(pb + 1)) { MKCTX; mixer_phase(C, l); }
        SYNC(pb + 1);
        if (IN(pb + 2)) { MKCTX; alpha_phase(C); }
        SYNC(pb + 2);
        if (IN(pb + 3)) {
            unsigned char* ws = launder(args.ws); unsigned char* wb = ws + WS_W + l * W_LAYER;
            pg8::Gemm g{(const bf16_t*)(ws + WS_MIX), (const bf16_t*)(wb + WO_OUT), M, DM, DM}; pg8::StaticOrder S; S.init(M, DM, G_, bid_);
            pg8::EpiResid E{(bf16_t*)(ws + WS_XB), (u64*)(ws + WS_SSQ) + (size_t)(2 * l + 1) * M, ldsp + EPI_STG_OFF};
            pg8::gemm_phase<pg8::EpiResid, pg8::StaticOrder, true, true>(ldsp, g, S, E);
        }
        SYNC(pb + 3);
        if (IN(pb + 4)) {
            unsigned char* ws = launder(args.ws); unsigned char* wb = ws + WS_W + l * W_LAYER;
            pg8::Gemm g{(const bf16_t*)(ws + WS_XB), (const bf16_t*)(wb + WO_UP), M, FF, DM}; pg8::StaticOrder S; S.init(M, FF, G_, bid_);
            pg8::EpiRowScale<1> E{(bf16_t*)(ws + WS_BIG), FF, (const u64*)(ws + WS_SSQ) + (size_t)(2 * l + 1) * M, FF, ldsp + EPI_STG_OFF};
            pg8::gemm_phase<pg8::EpiRowScale<1>, pg8::StaticOrder, true, true>(ldsp, g, S, E);
        }
        SYNC(pb + 4);
        if (IN(pb + 5)) {
            unsigned char* ws = launder(args.ws); unsigned char* wb = ws + WS_W + l * W_LAYER;
            pg8::Gemm g{(const bf16_t*)(ws + WS_BIG), (const bf16_t*)(wb + WO_DN), M, DM, FF}; pg8::StaticOrder S; S.init(M, DM, G_, bid_);
            pg8::EpiResid E{(bf16_t*)(ws + WS_XB), (u64*)(ws + WS_SSQ) + (size_t)(2 * l + 2) * M, ldsp + EPI_STG_OFF};
            pg8::gemm_phase<pg8::EpiResid, pg8::StaticOrder, true, true>(ldsp, g, S, E);
        }
        SYNC(pb + 5);
    }
    if (IN(13)) { MKCTX; final_phase(C); }
#undef IN
#undef SYNC
#undef MKCTX
}

extern "C" void kernel_launch(void* const* d_in, const int* in_sizes, int n_in, void* d_out, int out_size, void* d_ws, size_t ws_size, hipStream_t stream) {
    static int grid = 0;
    if (grid == 0) {
        if (n_in != 19 || in_sizes[0] != M * DM || out_size != M * DM || ws_size < WS_END) { fprintf(stderr, "kernel_launch: unexpected shapes (n_in %d, in0 %d, out %d, ws %zu)\n", n_in, n_in > 0 ? in_sizes[0] : -1, out_size, ws_size); grid = -1; return; }
        int dev = 0, cus = 0, per_cu = 0;
        if (hipGetDevice(&dev) != hipSuccess || hipDeviceGetAttribute(&cus, hipDeviceAttributeMultiprocessorCount, dev) != hipSuccess) { grid = -1; return; }
        if (hipFuncSetAttribute((const void*)fwd_kernel, hipFuncAttributeMaxDynamicSharedMemorySize, LDS_BYTES) != hipSuccess) { fprintf(stderr, "kernel_launch: hipFuncSetAttribute failed\n"); grid = -1; return; }
        if (hipOccupancyMaxActiveBlocksPerMultiprocessor(&per_cu, (const void*)fwd_kernel, 512, LDS_BYTES) != hipSuccess || per_cu < 1) { fprintf(stderr, "kernel_launch: occupancy query says %d\n", per_cu); per_cu = 1; }
        (void)hipGetLastError();
        grid = cus * per_cu;
    }
    if (grid < 0) return;
    Args a{};
    for (int i = 0; i < 19; ++i) a.in[i] = (const float*)d_in[i];
    a.out = (float*)d_out; a.ws = (unsigned char*)d_ws;
#if ONE_LAUNCH
    a.ph_lo = 0; a.ph_hi = N_PHASES;
    void* kargs[] = {&a};
    hipError_t e = hipLaunchCooperativeKernel((const void*)fwd_kernel, dim3(grid), dim3(512), kargs, LDS_BYTES, stream);
    if (e != hipSuccess) fprintf(stderr, "cooperative launch failed: %s (grid %d)\n", hipGetErrorString(e), grid);
#else
    for (int p = 0; p < N_PHASES; ++p) { a.ph_lo = p; a.ph_hi = p + 1; hipLaunchKernelGGL(fwd_kernel, dim3(grid), dim3(512), LDS_BYTES, stream, a); }
#endif
}
```

```cpp
#include <hip/hip_runtime.h>
#include <hip/hip_cooperative_groups.h>
#include <cstdio>
#include <cstdint>
namespace cg = cooperative_groups;

#ifndef ONE_LAUNCH
#define ONE_LAUNCH 1
#endif

#define LAS __attribute__((address_space(3)))
typedef unsigned short bf16_t;
typedef short bf16x8 __attribute__((ext_vector_type(8)));
typedef float f32x4 __attribute__((ext_vector_type(4)));
typedef float f32x2 __attribute__((ext_vector_type(2)));
typedef unsigned u32x4 __attribute__((ext_vector_type(4)));
typedef unsigned u32x2 __attribute__((ext_vector_type(2)));
typedef short v4i16_t __attribute__((ext_vector_type(4)));
typedef unsigned long long u64;

constexpr int DM = 1024, BATCH = 32, SEQ = 2048, M = BATCH * SEQ;
constexpr int HD = 64, AW = 384, CW = 256, LW = 384, INC = 2432, INP = 2560, FF = 4096;
constexpr int Q0 = 0, K0 = 384, V0 = 768, CA0 = 1152, CG0 = 1408, LG0 = 1664, LX0 = 2048;
constexpr float RMS_EPS = 1e-6f, LN_EPS = 1e-5f;
constexpr float LOG2E = 1.4426950408889634f, LN2 = 0.6931471805599453f;

constexpr size_t MiB = 1u << 20;
constexpr size_t WS_CTR = 0, WS_BAR = 65536;
constexpr size_t WS_CTR_UNUSED = 0;
constexpr size_t WS_W = 2 * MiB, W_LAYER = 23 * MiB;
constexpr size_t WO_IN = 0, WO_OUT = 5 * MiB, WO_UP = 7 * MiB, WO_DN = 15 * MiB;
constexpr size_t WS_SSQ = 48 * MiB;
constexpr size_t WS_LSE = 51 * MiB;
constexpr size_t WS_XB = 53 * MiB;
constexpr size_t WS_BIG = 181 * MiB;
constexpr size_t WS_Z = WS_BIG, WS_MIX = WS_BIG + 304 * MiB, WS_AO = WS_BIG + 432 * MiB;
constexpr size_t WS_Y2 = WS_BIG + 480 * MiB, WS_SUM = WS_BIG + 528 * MiB;
constexpr size_t WS_WTG = 1 * MiB;
constexpr size_t WS_END = WS_BIG + 530 * MiB;
constexpr int N_LRUC = 6 * BATCH * 16, N_ATT = BATCH * 96;

constexpr int LDS_BYTES = 151552;
constexpr int EPI_STG_OFF = 131072 + 1024, EPI_STG_SLICE = 2304;
constexpr int MISC_OFF = 131072;

__device__ __forceinline__ float bf_lo(unsigned w) { return __uint_as_float(w << 16); }
__device__ __forceinline__ float bf_hi(unsigned w) { return __uint_as_float(w & 0xffff0000u); }
__device__ __forceinline__ float bf2f(bf16_t b) { return __uint_as_float((unsigned)b << 16); }
__device__ __forceinline__ unsigned f2bf(float f) { unsigned u = __float_as_uint(f); return (u + 0x7fffu + ((u >> 16) & 1u)) >> 16; }
__device__ __forceinline__ unsigned pk2(float lo, float hi) { return f2bf(lo) | (f2bf(hi) << 16); }
__device__ __forceinline__ unsigned cvt_pk_bf16(float lo, float hi) { unsigned r; asm volatile("v_cvt_pk_bf16_f32 %0, %1, %2" : "=v"(r) : "v"(lo), "v"(hi)); return r; }
__device__ __forceinline__ float sigmoidf_(float x) { return __builtin_amdgcn_rcpf(1.f + __expf(-x)); }
__device__ __forceinline__ float wave_sum(float v) {
#pragma unroll
    for (int o = 1; o < 64; o <<= 1) v += __shfl_xor(v, o);
    return v;
}
__device__ __forceinline__ float rinv_from(u64 v) { return rsqrtf((float)v * (1.0f / 16777216.0f) * (1.0f / 1024.0f) + RMS_EPS); }

namespace pg8 {
constexpr int BM = 256, BK = 64, HALF = 128, HTB = HALF * BK * 2, STAGE_BYTES = 8 * HTB, NXCD = 8, WGM = 8;
__host__ __device__ __forceinline__ int lds_byte(int r, int c) { const int st = (r >> 4) * 2 + (c >> 5), rr = r & 15, cc = c & 31, ob = rr * 64 + cc * 2; return st * 1024 + (ob ^ (((ob >> 9) & 1) << 5)); }
__host__ __device__ __forceinline__ void stage_rc(int b, int& R, int& C) { const int st = b / 1024, sb = b % 1024, swz = sb ^ (((sb >> 9) & 1) << 5); R = (st >> 1) * 16 + swz / 64; C = (st & 1) * 32 + (swz % 64) / 2; }
__host__ __device__ __forceinline__ int perm32(int rho) { const int n = rho >> 4, i = rho & 15; return 8 * (i >> 2) + 4 * n + (i & 3); }

struct Unit { int pm, pn; };
struct Gemm { const bf16_t* A; const bf16_t* Bt; int M, N, K; };

struct StaticOrder {
    int nM, nN, nwg, G, c;
    __host__ __device__ void init(int M_, int N_, int G_, int c_) { nM = M_ / BM; nN = N_ / BM; nwg = nM * nN; G = G_; c = c_; }
    __host__ __device__ bool next(int i, Unit& u) const {
        const long L = (long)i * G + c; if (L >= nwg) return false;
        int wgid = (int)L; { const int q = nwg / NXCD, r = nwg % NXCD, xcd = wgid % NXCD, off = wgid / NXCD; wgid = (xcd < r ? xcd * (q + 1) : r * (q + 1) + (xcd - r) * q) + off; }
        const int nig = WGM * nN, gid = wgid / nig, fm = gid * WGM, gsz = (nM - fm) < WGM ? (nM - fm) : WGM;
        u.pm = fm + ((wgid % nig) % gsz); u.pn = (wgid % nig) / gsz; return true;
    }
    __device__ __forceinline__ void a_ready(const Unit&) const {}
    __device__ __forceinline__ void done(const Unit&) const {}
};

template <int ACT> struct EpiRowScale {
    static constexpr bool PERM = true, AFTER_DRAIN = false;
    bf16_t* O; int ldc; const u64* ssq; int nvalid; LAS unsigned char* stg;
    __device__ __forceinline__ void operator()(const f32x4 (&acc)[2][2][4][2], const Unit& u, int wr, int wc, int fr, int fq) const {
        const int ln = fr + 16 * fq; const int colw = u.pn * BM + 64 * wc;
        if (colw >= nvalid) return;
        float rl[2];
#pragma unroll
        for (int ai = 0; ai < 2; ++ai) rl[ai] = rinv_from(ssq[u.pm * BM + ai * HALF + wr * 64 + ln]);
        LAS unsigned char* sl = stg + (wr * 4 + wc) * EPI_STG_SLICE;
        const int rr = ln >> 3, cc = ln & 7;
#pragma unroll
        for (int ai = 0; ai < 2; ++ai)
#pragma unroll
            for (int m = 0; m < 4; ++m) {
                const float sc = __shfl(rl[ai], 16 * m + fr);
#pragma unroll
                for (int bj = 0; bj < 2; ++bj) {
                    f32x4 v0 = acc[ai][bj][m][0] * sc, v1 = acc[ai][bj][m][1] * sc;
                    if (ACT == 1) {
#pragma unroll
                        for (int e = 0; e < 4; ++e) { float a = fmaxf(v0[e], 0.f), b = fmaxf(v1[e], 0.f); v0[e] = a * a; v1[e] = b * b; }
                    }
                    u32x4 w; w.x = cvt_pk_bf16(v0[0], v0[1]); w.y = cvt_pk_bf16(v0[2], v0[3]); w.z = cvt_pk_bf16(v1[0], v1[1]); w.w = cvt_pk_bf16(v1[2], v1[3]);
                    *(LAS u32x4*)(sl + fr * 144 + bj * 64 + fq * 16) = w;
                }
                const int rowb = u.pm * BM + ai * HALF + wr * 64 + m * 16;
#pragma unroll
                for (int i = 0; i < 2; ++i) { const int r = rr + 8 * i; const u32x4 q = *(const LAS u32x4*)(sl + r * 144 + cc * 16);
                    __builtin_nontemporal_store(q, (u32x4*)(O + (size_t)(rowb + r) * ldc + colw + cc * 8)); }
            }
    }
};
struct EpiResid {
    static constexpr bool PERM = true, AFTER_DRAIN = false;
    bf16_t* xb; u64* ssq; LAS unsigned char* stg;
    __device__ __forceinline__ void operator()(const f32x4 (&acc)[2][2][4][2], const Unit& u, int wr, int wc, int fr, int fq) const {
        const int ln = fr + 16 * fq, rr = ln >> 3, cc = ln & 7; const int colw = u.pn * BM + 64 * wc;
        LAS unsigned char* sl = stg + (wr * 4 + wc) * EPI_STG_SLICE;
#pragma unroll
        for (int ai = 0; ai < 2; ++ai) {
            float qs[4];
#pragma unroll
            for (int mh = 0; mh < 2; ++mh) {
            u32x4 bs[4][2];
#pragma unroll
            for (int m = 2 * mh; m < 2 * mh + 2; ++m) { const int rowb = u.pm * BM + ai * HALF + wr * 64 + m * 16;
#pragma unroll
                for (int i = 0; i < 2; ++i) bs[m][i] = *(const u32x4*)(xb + (size_t)(rowb + rr + 8 * i) * DM + colw + cc * 8); }
#pragma unroll
            for (int m = 2 * mh; m < 2 * mh + 2; ++m) {
                const int rowb = u.pm * BM + ai * HALF + wr * 64 + m * 16; float q = 0.f;
#pragma unroll
                for (int i = 0; i < 2; ++i) *(LAS u32x4*)(sl + (rr + 8 * i) * 144 + cc * 16) = bs[m][i];
#pragma unroll
                for (int bj = 0; bj < 2; ++bj) {
                    const u32x4 b4 = *(const LAS u32x4*)(sl + fr * 144 + bj * 64 + fq * 16);
                    const f32x4 a0 = acc[ai][bj][m][0], a1 = acc[ai][bj][m][1];
                    const float o0 = bf_lo(b4.x) + a0[0], o1 = bf_hi(b4.x) + a0[1], o2 = bf_lo(b4.y) + a0[2], o3 = bf_hi(b4.y) + a0[3];
                    const float o4 = bf_lo(b4.z) + a1[0], o5 = bf_hi(b4.z) + a1[1], o6 = bf_lo(b4.w) + a1[2], o7 = bf_hi(b4.w) + a1[3];
                    q += ((o0 * o0 + o1 * o1) + (o2 * o2 + o3 * o3)) + ((o4 * o4 + o5 * o5) + (o6 * o6 + o7 * o7));
                    u32x4 w; w.x = cvt_pk_bf16(o0, o1); w.y = cvt_pk_bf16(o2, o3); w.z = cvt_pk_bf16(o4, o5); w.w = cvt_pk_bf16(o6, o7);
                    *(LAS u32x4*)(sl + fr * 144 + bj * 64 + fq * 16) = w;
                }
#pragma unroll
                for (int i = 0; i < 2; ++i) { const u32x4 qv = *(const LAS u32x4*)(sl + (rr + 8 * i) * 144 + cc * 16);
                    *(u32x4*)(xb + (size_t)(rowb + rr + 8 * i) * DM + colw + cc * 8) = qv; }
                q += __shfl_xor(q, 16); q += __shfl_xor(q, 32); qs[m] = q;
            }
            asm volatile("" ::: "memory");
            }
            { const float mine = fq == 0 ? qs[0] : (fq == 1 ? qs[1] : (fq == 2 ? qs[2] : qs[3]));
              __hip_atomic_fetch_add(ssq + (u.pm * BM + ai * HALF + wr * 64 + 16 * fq + fr), (u64)(mine * 16777216.0f), __ATOMIC_RELAXED, __HIP_MEMORY_SCOPE_AGENT); }
            asm volatile("" ::: "memory");
        }
    }
};

template <class Epi, class Sched, bool ALIGN_EPI = false, bool SP2 = false>
__device__ __forceinline__ void gemm_phase(LAS unsigned char* lds, const Gemm g, const Sched& S, const Epi& E) {
    int tid_ = (int)threadIdx.x; asm volatile("" : "+v"(tid_));
    const int tid = tid_, wid = __builtin_amdgcn_readfirstlane(tid >> 6), lane = tid & 63, wr = wid >> 2, wc = wid & 3, fr = lane & 15, fq = lane >> 4;
    const int K = g.K, nt = K / BK;
    unsigned voffA[2], voffB[2];
#pragma unroll
    for (int i = 0; i < 2; ++i) { int R, C; stage_rc(tid * 16 + i * 8192, R, C); const int Rb = Epi::PERM ? ((R & ~31) + perm32(R & 31)) : R;
        voffA[i] = (unsigned)(R * K + C) * 2u; voffB[i] = (unsigned)(Rb * K + C) * 2u; }
    const size_t kstep = (size_t)(BK * 2);
    const size_t hstep = (size_t)HALF * K * 2;
    const size_t tstep = 2 * hstep;
    const unsigned ldsw = (unsigned)wid * 1024u;
    const int aoff = lds_byte(wr * 64 + fr, fq * 8), boff = lds_byte(wc * 32 + fr, fq * 8);
#define PG8_SA(b, h) (((b) * 2 + (h)) * HTB)
#define PG8_SB(b, h) ((4 + (b) * 2 + (h)) * HTB)
#define PG8_STAGE(bufoff, gbase, voff) do { _Pragma("unroll") for (int _i = 0; _i < 2; ++_i) \
        __builtin_amdgcn_global_load_lds((const unsigned*)((const char*)(gbase) + (voff)[_i]), (LAS unsigned*)(lds + (bufoff) + ldsw + _i * 8192), 16, 0, 0); } while (0)
#define PG8_LDA(dst, b, h) do { _Pragma("unroll") for (int m = 0; m < 4; ++m) _Pragma("unroll") for (int k = 0; k < 2; ++k) dst[m][k] = *(const LAS bf16x8*)(lds + PG8_SA(b, h) + aoff + m * 2048 + k * 1024); } while (0)
#define PG8_LDB(dst, b, h) do { _Pragma("unroll") for (int n = 0; n < 2; ++n) _Pragma("unroll") for (int k = 0; k < 2; ++k) dst[n][k] = *(const LAS bf16x8*)(lds + PG8_SB(b, h) + boff + n * 2048 + k * 1024); } while (0)
#define PG8_MMA(ai, bj, At, Bt) do { __builtin_amdgcn_s_setprio(1); _Pragma("unroll") for (int m = 0; m < 4; ++m) _Pragma("unroll") for (int n = 0; n < 2; ++n) _Pragma("unroll") for (int k = 0; k < 2; ++k) \
        acc[ai][bj][m][n] = __builtin_amdgcn_mfma_f32_16x16x32_bf16(Bt[n][k], At[m][k], acc[ai][bj][m][n], 0, 0, 0); __builtin_amdgcn_s_setprio(0); } while (0)
#define PG8_WAIT_V(n) asm volatile("s_waitcnt vmcnt(" #n ")" ::: "memory")
#define PG8_WAIT_L(n) asm volatile("s_waitcnt lgkmcnt(" #n ")" ::: "memory")
#define PG8_BAR __builtin_amdgcn_s_barrier()
#define PG8_SCHED __builtin_amdgcn_sched_barrier(0)
    Unit cur, nxt; int ui = 0;
    if (!S.next(0, cur)) return;
    f32x4 acc[2][2][4][2];
#pragma unroll
    for (int a = 0; a < 2; ++a)
#pragma unroll
        for (int b = 0; b < 2; ++b)
#pragma unroll
            for (int m = 0; m < 4; ++m)
#pragma unroll
                for (int n = 0; n < 2; ++n) acc[a][b][m][n] = (f32x4){0.f, 0.f, 0.f, 0.f};
    bf16x8 At[4][2], B0[2][2], B1[2][2];
    const char* cA = (const char*)g.A + (size_t)cur.pm * tstep; const char* cB = (const char*)g.Bt + (size_t)cur.pn * tstep;
    S.a_ready(cur);
    if constexpr (SP2) {
        PG8_STAGE(PG8_SB(0, 0), cB, voffB); PG8_STAGE(PG8_SB(0, 1), cB + hstep, voffB); PG8_STAGE(PG8_SA(0, 0), cA, voffA); PG8_STAGE(PG8_SA(0, 1), cA + hstep, voffA);
        if (wr == 1) PG8_BAR;
        PG8_WAIT_V(2); PG8_BAR;
        PG8_STAGE(PG8_SB(1, 0), cB + kstep, voffB); PG8_STAGE(PG8_SA(1, 0), cA + kstep, voffA); PG8_STAGE(PG8_SB(1, 1), cB + hstep + kstep, voffB);
        PG8_WAIT_V(6); PG8_BAR;
    } else {
        PG8_STAGE(PG8_SB(0, 0), cB, voffB); PG8_STAGE(PG8_SA(0, 0), cA, voffA); PG8_STAGE(PG8_SB(0, 1), cB + hstep, voffB); PG8_STAGE(PG8_SA(0, 1), cA + hstep, voffA);
        if (wr == 1) PG8_BAR;
        PG8_WAIT_V(4); PG8_BAR;
        PG8_STAGE(PG8_SB(1, 0), cB + kstep, voffB); PG8_STAGE(PG8_SA(1, 0), cA + kstep, voffA); PG8_STAGE(PG8_SB(1, 1), cB + hstep + kstep, voffB);
        PG8_WAIT_V(6); PG8_BAR;
    }
    for (;;) {
        const bool has_next = S.next(ui + 1, nxt);
        const char* nA = has_next ? (const char*)g.A + (size_t)nxt.pm * tstep : cA; const char* nB = has_next ? (const char*)g.Bt + (size_t)nxt.pn * tstep : cB;
        for (int t = 0; t < nt; t += 2) {
            const bool last = (t == nt - 2);
            const char* a1 = cA + (size_t)(t + 1) * kstep;
            const char* a2 = last ? nA : cA + (size_t)(t + 2) * kstep; const char* b2 = last ? nB : cB + (size_t)(t + 2) * kstep;
            const char* a3 = a2 + kstep; const char* b3 = b2 + kstep;
            if (last && has_next) S.a_ready(nxt);
            if constexpr (SP2) {
            PG8_LDB(B0, 0, 0); PG8_LDB(B1, 0, 1); PG8_SCHED; PG8_LDA(At, 0, 0); PG8_STAGE(PG8_SA(1, 1), a1 + hstep, voffA);
            PG8_WAIT_V(8); PG8_WAIT_L(0); PG8_BAR; PG8_MMA(0, 0, At, B0); PG8_MMA(0, 1, At, B1); PG8_BAR; PG8_SCHED;
            PG8_LDA(At, 0, 1); PG8_STAGE(PG8_SB(0, 0), b2, voffB); PG8_STAGE(PG8_SB(0, 1), b2 + hstep, voffB); PG8_STAGE(PG8_SA(0, 0), a2, voffA);
            PG8_WAIT_V(8); PG8_WAIT_L(0); PG8_BAR; PG8_MMA(1, 0, At, B0); PG8_MMA(1, 1, At, B1); PG8_BAR; PG8_SCHED;
            PG8_LDB(B0, 1, 0); PG8_LDB(B1, 1, 1); PG8_SCHED; PG8_LDA(At, 1, 0); PG8_STAGE(PG8_SA(0, 1), a2 + hstep, voffA);
            PG8_WAIT_V(8); PG8_WAIT_L(0); PG8_BAR; PG8_MMA(0, 0, At, B0); PG8_MMA(0, 1, At, B1); PG8_BAR; PG8_SCHED;
            PG8_LDA(At, 1, 1); PG8_STAGE(PG8_SB(1, 0), b3, voffB); PG8_STAGE(PG8_SB(1, 1), b3 + hstep, voffB); PG8_STAGE(PG8_SA(1, 0), a3, voffA);
            PG8_WAIT_V(8); PG8_WAIT_L(0); PG8_BAR; PG8_MMA(1, 0, At, B0); PG8_MMA(1, 1, At, B1); PG8_BAR; PG8_SCHED;
            } else {
            PG8_LDB(B0, 0, 0); PG8_SCHED; PG8_LDA(At, 0, 0); PG8_STAGE(PG8_SA(1, 1), a1 + hstep, voffA);
            PG8_WAIT_L(8); PG8_BAR; PG8_WAIT_L(0); PG8_MMA(0, 0, At, B0); PG8_BAR; PG8_SCHED;
            PG8_LDB(B1, 0, 1); PG8_STAGE(PG8_SB(0, 0), b2, voffB);
            PG8_BAR; PG8_WAIT_L(0); PG8_MMA(0, 1, At, B1); PG8_BAR;
            PG8_LDA(At, 0, 1); PG8_STAGE(PG8_SA(0, 0), a2, voffA);
            PG8_BAR; PG8_WAIT_L(0); PG8_MMA(1, 0, At, B0); PG8_BAR; PG8_SCHED;
            PG8_STAGE(PG8_SB(0, 1), b2 + hstep, voffB);
            PG8_WAIT_V(6); PG8_BAR; PG8_MMA(1, 1, At, B1); PG8_BAR;
            PG8_LDB(B0, 1, 0); PG8_SCHED; PG8_LDA(At, 1, 0); PG8_STAGE(PG8_SA(0, 1), a2 + hstep, voffA);
            PG8_WAIT_L(8); PG8_BAR; PG8_WAIT_L(0); PG8_MMA(0, 0, At, B0); PG8_BAR; PG8_SCHED;
            PG8_LDB(B1, 1, 1); PG8_STAGE(PG8_SB(1, 0), b3, voffB);
            PG8_BAR; PG8_WAIT_L(0); PG8_MMA(0, 1, At, B1); PG8_BAR;
            PG8_LDA(At, 1, 1); PG8_STAGE(PG8_SA(1, 0), a3, voffA);
            PG8_BAR; PG8_WAIT_L(0); PG8_MMA(1, 0, At, B0); PG8_BAR; PG8_SCHED;
            PG8_STAGE(PG8_SB(1, 1), b3 + hstep, voffB);
            PG8_WAIT_V(6); PG8_BAR; PG8_MMA(1, 1, At, B1); PG8_BAR;
            }
        }
        if constexpr (ALIGN_EPI) { if (wr == 0) PG8_BAR; }
        if constexpr (!Epi::AFTER_DRAIN) { E(acc, cur, wr, wc, fr, fq); S.done(cur); }
        if (!has_next) break;
#pragma unroll
        for (int a = 0; a < 2; ++a)
#pragma unroll
            for (int b = 0; b < 2; ++b)
#pragma unroll
                for (int m = 0; m < 4; ++m)
#pragma unroll
                    for (int n = 0; n < 2; ++n) acc[a][b][m][n] = (f32x4){0.f, 0.f, 0.f, 0.f};
        cur = nxt; cA = nA; cB = nB; ++ui;
        if constexpr (ALIGN_EPI) { if (wr == 1) PG8_BAR; }
    }
    PG8_WAIT_V(0);
    if constexpr (!ALIGN_EPI) { if (wr == 0) PG8_BAR; }
    PG8_BAR;
#undef PG8_SA
#undef PG8_SB
#undef PG8_STAGE
#undef PG8_LDA
#undef PG8_LDB
#undef PG8_MMA
#undef PG8_WAIT_V
#undef PG8_WAIT_L
#undef PG8_BAR
#undef PG8_SCHED
}
}

typedef __attribute__((address_space(1))) unsigned char gchar_t;
__device__ __forceinline__ unsigned char* launder(unsigned char* p) { size_t z = 0; asm volatile("" : "+s"(z)); return p + z; }
__device__ __forceinline__ const float* gptr(const float* p) { return (const float*)(const __attribute__((address_space(1))) float*)p; }
__device__ __forceinline__ int launder_v(int x) { asm volatile("" : "+v"(x)); return x; }

#define XB_TMO      128
#define XB_XCNT(j)  (256  + 64 * (j))
#define XB_XSUB(j)  (1280 + 64 * (j))
#define XB_XGEN(j)  (2304 + 64 * (j))
#define XB_TOP      3328
#define XB_TOPGEN   3392
#define XCD_BAR_WORDS 3456
#define XB_SPIN_CAP (1u << 18)
__device__ __forceinline__ unsigned xb_ld(unsigned* p)              { return __hip_atomic_load(p, __ATOMIC_RELAXED, __HIP_MEMORY_SCOPE_AGENT); }
__device__ __forceinline__ unsigned xb_add(unsigned* p, unsigned v) { return __hip_atomic_fetch_add(p, v, __ATOMIC_RELAXED, __HIP_MEMORY_SCOPE_AGENT); }
__device__ __forceinline__ unsigned xb_xcc_id() { return (unsigned)__builtin_amdgcn_s_getreg((3 << 11) | 20) & 0xFu; }
#define XB_SPIN(cond, bar) do { unsigned _sp = 0; while (cond) { __builtin_amdgcn_s_sleep(1); \
    if ((++_sp & 255u) == 0u) { if (xb_ld(&(bar)[XB_TMO])) break; if (_sp > XB_SPIN_CAP) { atomicAdd(&(bar)[XB_TMO], 1u); break; } } } } while (0)
struct XcdBarrier { unsigned* bar; unsigned x; volatile LAS unsigned* st; };
__device__ __forceinline__ XcdBarrier xcd_barrier_post(unsigned* bar, volatile LAS unsigned* st) {
    XcdBarrier b; b.bar = bar; b.x = xb_xcc_id(); b.st = st;
    if (threadIdx.x == 0) (void)xb_add(&bar[XB_XCNT(b.x)], 1u);
    return b;
}
__device__ __forceinline__ void xcd_barrier_complete(unsigned* bar, unsigned x, unsigned& nloc, unsigned& nx) {
    const unsigned G = gridDim.x * gridDim.y * gridDim.z;
    unsigned sum, cnt, mine, sp = 0u;
    for (;;) {
        sum = 0u; cnt = 0u; mine = 0u;
#pragma unroll
        for (unsigned j = 0; j < 16; ++j) { const unsigned c = xb_ld(&bar[XB_XCNT(j)]); sum += c; cnt += (c > 0u) ? 1u : 0u; mine = (j == x) ? c : mine; }
        if (sum == G) break;
        __builtin_amdgcn_s_sleep(1);
        if ((++sp & 255u) == 0u) { if (xb_ld(&bar[XB_TMO])) break; if (sp > XB_SPIN_CAP) { atomicAdd(&bar[XB_TMO], 1u); break; } }
    }
    nloc = mine > 0u ? mine : 1u; nx = cnt > 0u ? cnt : 1u;
}
__device__ __forceinline__ void xcd_barrier(const XcdBarrier& b) {
    asm volatile("s_waitcnt vmcnt(0)" ::: "memory");
    __syncthreads();
    if (threadIdx.x == 0) {
        unsigned* bar = b.bar;
        __builtin_amdgcn_s_waitcnt(0);
        unsigned nloc = b.st[0], nx = b.st[1];
        if (nloc == 0u) { xcd_barrier_complete(bar, b.x, nloc, nx); b.st[0] = nloc; b.st[1] = nx; }
        const unsigned old = xb_add(&bar[XB_XSUB(b.x)], 1u);
        const unsigned gen = old / nloc;
        if (old + 1u == (gen + 1u) * nloc) {
            __builtin_amdgcn_fence(__ATOMIC_RELEASE, "agent");
            asm volatile("s_waitcnt vmcnt(0)" ::: "memory");
            const unsigned og = xb_add(&bar[XB_TOP], 1u);
            const unsigned tg = og / nx;
            if (og + 1u == (tg + 1u) * nx) xb_add(&bar[XB_TOPGEN], 1u);
            else XB_SPIN(xb_ld(&bar[XB_TOPGEN]) == tg, bar);
            __builtin_amdgcn_fence(__ATOMIC_ACQUIRE, "agent");
            xb_add(&bar[XB_XGEN(b.x)], 1u);
            asm volatile("s_waitcnt vmcnt(0)" ::: "memory");
        } else {
            XB_SPIN(xb_ld(&bar[XB_XGEN(b.x)]) == gen, bar);
            __builtin_amdgcn_fence(__ATOMIC_ACQUIRE, "agent");
            asm volatile("s_waitcnt vmcnt(0)" ::: "memory");
        }
    }
    __syncthreads();
}
struct Args { const float* in[19]; float* out; unsigned char* ws; int ph_lo, ph_hi; };

struct Ctx {
    const float* const* in; float* out; unsigned char* ws;
    LAS unsigned char* lds; int tid, lane, wave, G, bid;
};

__host__ __device__ __forceinline__ int wrow(int n) { return (n & ~255) | (((n >> 5) & 1) << 7) | (((n >> 6) & 3) << 5) | (n & 31); }
__device__ __forceinline__ void tr_item(const float* W, int K, int N, bf16_t* WT, const float* gs, LAS float* scr, int item, int lane) {
    const int nblk = N / 32, kb = item / nblk, nb = item % nblk, k0 = 64 * kb, n0 = 32 * nb;
    const int c4 = (lane & 7) * 4;
#pragma unroll
    for (int i = 0; i < 8; ++i) { const int kk = 8 * i + (lane >> 3); const float s = gs ? gs[k0 + kk] : 1.f; const f32x4 v = *(const f32x4*)(W + (size_t)(k0 + kk) * N + n0 + c4) * s;
        LAS float* d = scr + kk * 33 + c4; d[0] = v[0]; d[1] = v[1]; d[2] = v[2]; d[3] = v[3]; }
    asm volatile("s_waitcnt lgkmcnt(0)" ::: "memory");
    const int c = lane & 7;
#pragma unroll
    for (int j = 0; j < 4; ++j) { const int n = (lane >> 3) + 8 * j; const LAS float* s = scr + (8 * c) * 33 + n;
        u32x4 o; o.x = pk2(s[0 * 33], s[1 * 33]); o.y = pk2(s[2 * 33], s[3 * 33]); o.z = pk2(s[4 * 33], s[5 * 33]); o.w = pk2(s[6 * 33], s[7 * 33]);
        *(u32x4*)(WT + (size_t)wrow(n0 + n) * K + k0 + 8 * c) = o; }
    asm volatile("s_waitcnt lgkmcnt(0)" ::: "memory");
}

__device__ __forceinline__ void prologue(const Ctx& C) {
    const int gw = C.bid * 8 + C.wave, NGW = C.G * 8; const int gt = C.bid * 512 + C.tid, NGT = C.G * 512;
    { u64* s = (u64*)(C.ws + WS_SSQ) + M; for (int i = gt; i < 4 * M; i += NGT) s[i] = 0ull;
      unsigned* ctr = (unsigned*)(C.ws + WS_CTR); if (gt < 64) ctr[gt] = 0u;
      unsigned* barw = (unsigned*)(C.ws + WS_BAR); if (gt < 3456) barw[gt] = 0u;
      for (int l = 0; l < 2; ++l) { bf16_t* wt = (bf16_t*)(C.ws + WS_W + l * W_LAYER + WO_IN); for (int i = gt; i < (INP - INC) * DM / 8; i += NGT) { const int n = INC + i / (DM / 8), ch = i % (DM / 8); *(u32x4*)(wt + (size_t)wrow(n) * DM + ch * 8) = (u32x4){0u, 0u, 0u, 0u}; } } }
    { bf16_t* wtg = (bf16_t*)(C.ws + WS_WTG);
      for (int i = gt; i < 2 * 6 * 2 * 4096; i += NGT) { const int o = i & 63, k = (i >> 6) & 63, mat = (i >> 12) & 1, lh = i >> 13;
          const float v = (mat ? gptr(C.in[11]) : gptr(C.in[9]))[(size_t)lh * 4096 + k * 64 + o]; wtg[((size_t)(lh * 2 + mat) * 64 + o) * 64 + k] = (bf16_t)f2bf(v); } }
    LAS float* scr = (LAS float*)(C.lds + C.wave * 16384);
    constexpr int I_IN = (DM / 64) * (INC / 32), I_OUT = (DM / 64) * (DM / 32), I_UP = (DM / 64) * (FF / 32), I_DN = (FF / 64) * (DM / 32), I_L = I_IN + I_OUT + I_UP + I_DN;
    for (int it = gw; it < 2 * I_L; it += NGW) {
        const int l = it / I_L; int r = it % I_L; unsigned char* wb = C.ws + WS_W + l * W_LAYER;
        if (r < I_IN) { tr_item(gptr(C.in[2]) + (size_t)l * DM * INC, DM, INC, (bf16_t*)(wb + WO_IN), gptr(C.in[1]) + l * DM, scr, r, C.lane); continue; } r -= I_IN;
        if (r < I_OUT) { tr_item(gptr(C.in[14]) + (size_t)l * DM * DM, DM, DM, (bf16_t*)(wb + WO_OUT), nullptr, scr, r, C.lane); continue; } r -= I_OUT;
        if (r < I_UP) { tr_item(gptr(C.in[16]) + (size_t)l * DM * FF, DM, FF, (bf16_t*)(wb + WO_UP), gptr(C.in[15]) + l * DM, scr, r, C.lane); continue; } r -= I_UP;
        tr_item(gptr(C.in[17]) + (size_t)l * FF * DM, FF, DM, (bf16_t*)(wb + WO_DN), nullptr, scr, r, C.lane);
    }
    const float* x = gptr(C.in[0]); bf16_t* xb = (bf16_t*)(C.ws + WS_XB); u64* ssq0 = (u64*)(C.ws + WS_SSQ);
    for (int m0 = gw * 4; m0 < M; m0 += NGW * 4) {
        f32x4 v[4][4]; float sq[4];
#pragma unroll
        for (int r = 0; r < 4; ++r) { const f32x4* xr = (const f32x4*)(x + (size_t)(m0 + r) * DM) + C.lane;
#pragma unroll
            for (int j = 0; j < 4; ++j) v[r][j] = xr[64 * j]; }
#pragma unroll
        for (int r = 0; r < 4; ++r) { float s = 0.f;
#pragma unroll
            for (int j = 0; j < 4; ++j) s += (v[r][j].x * v[r][j].x + v[r][j].y * v[r][j].y) + (v[r][j].z * v[r][j].z + v[r][j].w * v[r][j].w);
            sq[r] = wave_sum(s); }
#pragma unroll
        for (int r = 0; r < 4; ++r) {
            if (C.lane == 0) ssq0[m0 + r] = (u64)(sq[r] * 16777216.0f);
            u32x2* o8 = (u32x2*)(xb + (size_t)(m0 + r) * DM) + C.lane;
#pragma unroll
            for (int j = 0; j < 4; ++j) { u32x2 w; w.x = pk2(v[r][j].x, v[r][j].y); w.y = pk2(v[r][j].z, v[r][j].w); o8[64 * j] = w; } }
    }
}

struct MixCtx { const bf16_t* Z; bf16_t* MIX; bf16_t* AO; float* LSE; bf16_t* Y2; float* SUM; const bf16_t* WTG; const float* const* in; int l; };
__device__ __forceinline__ MixCtx mk_mix(unsigned char* ws, const float* const* in, int l) { ws = launder(ws); asm volatile("" : "+s"(l));
    MixCtx X; X.Z = (const bf16_t*)(ws + WS_Z); X.MIX = (bf16_t*)(ws + WS_MIX); X.AO = (bf16_t*)(ws + WS_AO); X.LSE = (float*)(ws + WS_LSE); X.Y2 = (bf16_t*)(ws + WS_Y2); X.SUM = (float*)(ws + WS_SUM); X.WTG = (const bf16_t*)(ws + WS_WTG); X.in = in; X.l = l; return X; }

struct AttnPre { u32x4 k[4], v[4]; bf16x8 q0, q1; };
__device__ __forceinline__ void attn_load(const bf16_t* Z, int a, int tid, AttnPre& P) {
    const int lane = tid & 63, w = tid >> 6;
    const int b = a / 96, rem = a % 96, h = rem >> 4, u16 = rem & 15;
    const int sh = 2 * (h >> 1), dil = 1 << sh, nbm = (16 >> sh) - 1;
    const int r = u16 >> (4 - sh), n = u16 & nbm;
    const bf16_t* zb = Z + (size_t)b * SEQ * INC;
#pragma unroll
    for (int i = 0; i < 4; ++i) { const int c = tid + 512 * i; const int row = c >> 3, ch = c & 7; const int sub = (n - 1) * 128 + row;
        P.k[i] = (u32x4){0u, 0u, 0u, 0u}; P.v[i] = (u32x4){0u, 0u, 0u, 0u};
        if (sub >= 0) { const size_t off = (size_t)(sub * dil + r) * INC + h * 64 + ch * 8; P.k[i] = *(const u32x4*)(zb + off + K0); P.v[i] = *(const u32x4*)(zb + off + V0); } }
    const int j = lane & 15, kq = lane >> 4; const int qi = 16 * w + j; const int qpos = (n * 128 + qi) * dil + r;
    const bf16_t* qp = zb + (size_t)qpos * INC + Q0 + h * 64 + kq * 8;
    P.q0 = *(const bf16x8*)qp; P.q1 = *(const bf16x8*)(qp + 32);
}
__device__ __forceinline__ void attn_compute(const MixCtx& X, int a, LAS unsigned char* lds, int tid, const bf16x8 q0, const bf16x8 q1) {
    const int lane = tid & 63, w = __builtin_amdgcn_readfirstlane(tid >> 6);
    const int b = a / 96, rem = a % 96, h = rem >> 4, u16 = rem & 15;
    const int sh = 2 * (h >> 1), dil = 1 << sh, nbm = (16 >> sh) - 1;
    const int r = u16 >> (4 - sh), n = u16 & nbm;
    const float slope = exp2f(-8.0f * (float)(h + 1) / 6.0f);
    const float c1 = 0.125f * LOG2E, c2 = slope * (float)dil * LOG2E;
    LAS unsigned char* Kl = lds; LAS unsigned char* Vl = lds + 39168;
    const int j = lane & 15, kq = lane >> 4;
    const int qi = 16 * w + j; const int qpos = (n * 128 + qi) * dil + r;
    float s[9][4]; float mx = -1e30f;
    const int d0 = j + 128 - 4 * kq;
    float be[4]; const float bstep = 16.0f * c2;
#pragma unroll
    for (int e = 0; e < 4; ++e) be[e] = -c2 * (float)(d0 - e);
    const int nlive0 = (n == 0) ? (8 - w) : 0;
#pragma unroll
    for (int tt = 0; tt < 9; ++tt) {
        if (tt >= nlive0) {
            const int kt = w + tt; const LAS unsigned char* p = Kl + (16 * kt + j) * 144 + kq * 16;
            const bf16x8 k0f = *(const LAS bf16x8*)p, k1f = *(const LAS bf16x8*)(p + 64);
            f32x4 acc = (f32x4){0.f, 0.f, 0.f, 0.f};
            acc = __builtin_amdgcn_mfma_f32_16x16x32_bf16(k0f, q0, acc, 0, 0, 0);
            acc = __builtin_amdgcn_mfma_f32_16x16x32_bf16(k1f, q1, acc, 0, 0, 0);
#pragma unroll
            for (int e = 0; e < 4; ++e) {
                float v = acc[e] * c1 + (be[e] + bstep * (float)tt);
                if (tt == 0) { if (d0 - e > 128) v = -1e30f; }
                if (tt == 8) { if (d0 - 128 - e < 0) v = -1e30f; }
                s[tt][e] = v; mx = fmaxf(mx, v); }
        } else {
#pragma unroll
            for (int e = 0; e < 4; ++e) s[tt][e] = -1e30f;
        }
    }
    mx = fmaxf(mx, __shfl_xor(mx, 16)); mx = fmaxf(mx, __shfl_xor(mx, 32));
    float l = 0.f;
#pragma unroll
    for (int tt = 0; tt < 9; ++tt) {
        if (tt >= nlive0) {
#pragma unroll
            for (int e = 0; e < 4; ++e) { const float pv = __builtin_amdgcn_exp2f(s[tt][e] - mx); s[tt][e] = pv; l += pv; }
        } else {
#pragma unroll
            for (int e = 0; e < 4; ++e) s[tt][e] = 0.f;
        }
    }
    l += __shfl_xor(l, 16); l += __shfl_xor(l, 32);
    f32x4 o[4];
#pragma unroll
    for (int dt = 0; dt < 4; ++dt) o[dt] = (f32x4){0.f, 0.f, 0.f, 0.f};
    const int qq = (lane & 15) >> 2, pp = lane & 3;
#pragma unroll
    for (int c = 0; c < 5; ++c) {
        if (2 * c + 1 >= nlive0) {
            u32x4 pw; pw.x = cvt_pk_bf16(s[2 * c][0], s[2 * c][1]); pw.y = cvt_pk_bf16(s[2 * c][2], s[2 * c][3]);
            if (c < 4) { pw.z = cvt_pk_bf16(s[2 * c + 1][0], s[2 * c + 1][1]); pw.w = cvt_pk_bf16(s[2 * c + 1][2], s[2 * c + 1][3]); } else { pw.z = 0u; pw.w = 0u; }
            const bf16x8 pb = __builtin_bit_cast(bf16x8, pw);
            const int row = 16 * (w + 2 * c) + 4 * kq + qq;
#pragma unroll
            for (int dt = 0; dt < 4; ++dt) {
                LAS unsigned char* vp = Vl + row * 160 + (16 * dt + 4 * pp) * 2;
                const v4i16_t lo = __builtin_amdgcn_ds_read_tr16_b64_v4i16((LAS v4i16_t*)vp);
                const v4i16_t hi = __builtin_amdgcn_ds_read_tr16_b64_v4i16((LAS v4i16_t*)(vp + 16 * 160));
                const bf16x8 vf = (bf16x8){lo[0], lo[1], lo[2], lo[3], hi[0], hi[1], hi[2], hi[3]};
                o[dt] = __builtin_amdgcn_mfma_f32_16x16x32_bf16(vf, pb, o[dt], 0, 0, 0);
            }
        }
    }
    const float inv = 1.0f / l;
    LAS unsigned char* so = lds + 82944 + w * 2304;
#pragma unroll
    for (int dt = 0; dt < 4; ++dt) { u32x2 wv; wv.x = cvt_pk_bf16(o[dt][0] * inv, o[dt][1] * inv); wv.y = cvt_pk_bf16(o[dt][2] * inv, o[dt][3] * inv); *(LAS u32x2*)(so + j * 144 + (16 * dt + 4 * kq) * 2) = wv; }
#pragma unroll
    for (int i = 0; i < 2; ++i) { const int rq = (lane >> 3) + 8 * i, cq = lane & 7; const int qpr = (n * 128 + 16 * w + rq) * dil + r;
        const u32x4 qv = *(const LAS u32x4*)(so + rq * 144 + cq * 16);
        *(u32x4*)(X.AO + ((size_t)b * SEQ + qpr) * AW + h * 64 + cq * 8) = qv; }
    if (kq == 0) X.LSE[((size_t)b * SEQ + qpos) * 6 + h] = (mx + __log2f(l)) * LN2;
}
__device__ __forceinline__ void attn_loop(unsigned char* ws_, const float* const* in_, int l_, LAS unsigned char* lds, int tid, int a_start, int a_cnt, int a_stride) {
    const MixCtx X = mk_mix(ws_, in_, l_); tid = launder_v(tid);
    LAS unsigned char* Kl = lds; LAS unsigned char* Vl = lds + 39168;
    if (tid < 128) { const int row = 256 + (tid >> 3), ch = tid & 7; const unsigned z = (unsigned)launder_v(0); const u32x4 zz = (u32x4){z, z, z, z}; *(LAS u32x4*)(Kl + row * 144 + ch * 16) = zz; *(LAS u32x4*)(Vl + row * 160 + ch * 16) = zz; }
    AttnPre P; int a = a_start;
    if (a_cnt > 0) attn_load(X.Z, a, tid, P);
    for (int k = 0; k < a_cnt; ++k, a += a_stride) {
        __syncthreads();
#pragma unroll
        for (int i = 0; i < 4; ++i) { const int c = tid + 512 * i; const int row = c >> 3, ch = c & 7;
            *(LAS u32x4*)(Kl + row * 144 + ch * 16) = P.k[i]; *(LAS u32x4*)(Vl + row * 160 + ch * 16) = P.v[i]; }
        const bf16x8 q0 = P.q0, q1 = P.q1;
        __syncthreads();
        if (k + 1 < a_cnt) attn_load(X.Z, a + a_stride, tid, P);
        attn_compute(X, a, lds, tid, q0, q1);
    }
    __syncthreads();
}

__device__ __forceinline__ void conv_glu8(const u32x4 av, const u32x4 gv, f32x4& u0, f32x4& u1) {
    u0[0] = bf_lo(av.x) * sigmoidf_(bf_lo(gv.x)); u0[1] = bf_hi(av.x) * sigmoidf_(bf_hi(gv.x)); u0[2] = bf_lo(av.y) * sigmoidf_(bf_lo(gv.y)); u0[3] = bf_hi(av.y) * sigmoidf_(bf_hi(gv.y));
    u1[0] = bf_lo(av.z) * sigmoidf_(bf_lo(gv.z)); u1[1] = bf_hi(av.z) * sigmoidf_(bf_hi(gv.z)); u1[2] = bf_lo(av.w) * sigmoidf_(bf_lo(gv.w)); u1[3] = bf_hi(av.w) * sigmoidf_(bf_hi(gv.w));
}
__device__ __forceinline__ int ring94(int r) { return r >= 94 ? r - 94 : r; }
template <int S> struct ConvStep {
    static __device__ __forceinline__ void run(float (&acc)[32], const float (&wv)[31], const LAS float* U, int rb, int cch) {
        const float uv = U[ring94(ring94(rb + S)) * 256 + cch];
#pragma unroll
        for (int o = 0; o < 32; ++o) { constexpr int dummy = 0; const int kk = S - o + dummy; if (kk >= 0 && kk <= 30) acc[o] += wv[kk] * uv; }
        ConvStep<S + 1>::run(acc, wv, U, rb, cch);
    }
};
template <> struct ConvStep<62> { static __device__ __forceinline__ void run(float (&)[32], const float (&)[31], const LAS float*, int, int) {} };
__device__ __forceinline__ void conv_loop(unsigned char* ws_, const float* const* in_, int l_, LAS unsigned char* lds, int tid, int bid, int G) {
    const MixCtx X = mk_mix(ws_, in_, l_); tid = launder_v(tid);
    const int lane = tid & 63, w = tid >> 6;
    LAS float* U = (LAS float*)lds;
    const int cch = tid & 255, half = tid >> 8;
    const float* cw = gptr(X.in[3]) + (size_t)X.l * 31 * CW; float wv[31]; int cwo = cch;
#pragma unroll
    for (int k = 0; k < 31; ++k) { wv[k] = cw[cwo]; cwo += CW; asm volatile("" : "+v"(cwo)); }
    const float bias = gptr(X.in[4])[X.l * CW + cch];
    const f32x4 gg = *(const f32x4*)(gptr(X.in[5]) + X.l * CW + 4 * lane), bb = *(const f32x4*)(gptr(X.in[6]) + X.l * CW + 4 * lane);
    for (int cc = bid; cc < BATCH * 8; cc += G) {
        const int b = cc >> 3, tb = (cc & 7) * 4;
        const bf16_t* zb = X.Z + (size_t)b * SEQ * INC;
        u32x4 pa[4], pg[4];
#pragma unroll
        for (int i = 0; i < 4; ++i) { const int idx = tid + 512 * i; const int row = idx >> 5, ch = idx & 31; const size_t t = (size_t)(tb * 64 + row);
            pa[i] = *(const u32x4*)(zb + t * INC + CA0 + ch * 8); pg[i] = *(const u32x4*)(zb + t * INC + CG0 + ch * 8); }
        __syncthreads();
#pragma unroll
        for (int i = 0; i < 2; ++i) { const int idx = tid + 512 * i; if (idx < 30 * 32) { const int row = idx >> 5, ch = idx & 31; const int t = tb * 64 - 30 + row;
            f32x4 u0 = (f32x4){0.f, 0.f, 0.f, 0.f}, u1 = u0;
            if (t >= 0) { const u32x4 av = *(const u32x4*)(zb + (size_t)t * INC + CA0 + ch * 8), gv = *(const u32x4*)(zb + (size_t)t * INC + CG0 + ch * 8); conv_glu8(av, gv, u0, u1); }
            *(LAS f32x4*)(U + row * 256 + ch * 8) = u0; *(LAS f32x4*)(U + row * 256 + ch * 8 + 4) = u1; } }
        int base = 0;
        for (int k = 0; k < 4; ++k) {
            const int t0 = (tb + k) * 64;
#pragma unroll
            for (int i = 0; i < 4; ++i) { const int idx = tid + 512 * i; const int row = ring94(base + 30 + (idx >> 5)), ch = idx & 31; f32x4 u0, u1; conv_glu8(pa[i], pg[i], u0, u1);
                *(LAS f32x4*)(U + row * 256 + ch * 8) = u0; *(LAS f32x4*)(U + row * 256 + ch * 8 + 4) = u1; }
            __syncthreads();
            if (k < 3) {
#pragma unroll
                for (int i = 0; i < 4; ++i) { const int idx = tid + 512 * i; const int row = idx >> 5, ch = idx & 31; const size_t t = (size_t)(t0 + 64 + row);
                    pa[i] = *(const u32x4*)(zb + t * INC + CA0 + ch * 8); pg[i] = *(const u32x4*)(zb + t * INC + CG0 + ch * 8); }
            }
            float acc[32];
#pragma unroll
            for (int o = 0; o < 32; ++o) acc[o] = bias;
            const int rb = base + 32 * half;
            ConvStep<0>::run(acc, wv, U, rb, cch);
            __syncthreads();
#pragma unroll
            for (int o = 0; o < 32; ++o) U[ring94(ring94(rb + o)) * 256 + cch] = acc[o];
            __syncthreads();
#pragma unroll
            for (int i = 0; i < 8; ++i) { const int tok = 8 * w + i; f32x4 v = *(LAS f32x4*)(U + ring94(base + tok) * 256 + 4 * lane);
                const float mean = wave_sum((v[0] + v[1]) + (v[2] + v[3])) * (1.0f / 256.0f);
                v = v - mean; const float var = wave_sum((v[0] * v[0] + v[1] * v[1]) + (v[2] * v[2] + v[3] * v[3])) * (1.0f / 256.0f);
                const float rstd = rsqrtf(var + LN_EPS); f32x4 y = v * rstd * gg + bb;
#pragma unroll
                for (int e = 0; e < 4; ++e) y[e] = y[e] * sigmoidf_(y[e]);
                u32x2 wv2; wv2.x = cvt_pk_bf16(y[0], y[1]); wv2.y = cvt_pk_bf16(y[2], y[3]);
                *(u32x2*)(X.MIX + ((size_t)b * SEQ + t0 + tok) * DM + AW + 4 * lane) = wv2; }
            __syncthreads();
            base = ring94(base + 64);
        }
    }
}

constexpr int LR_UB = 0, LR_A = 18432, LR_B = 53248, LR_WT = 88064, LR_PRM = 106496, LR_SA = 107264, LR_SB = 109312, LR_GT = 111360, LR_CAR = 129792;
__device__ __forceinline__ float gelu_tanh(float x) { const float y = 0.7978845608028654f * (x + 0.044715f * x * x * x); const float e = __expf(2.f * y); return 0.5f * x * (2.f - 2.f * __builtin_amdgcn_rcpf(1.f + e)); }
struct LruPre { u32x4 x[5], g[2]; };
__device__ __forceinline__ void lru_load(const MixCtx& X, int b, int h, int chunk, int tid, LruPre& P) {
    const int c0 = h * 64, t0 = chunk * 128;
    const bf16_t* zb = X.Z + (size_t)b * SEQ * INC; const int cg8 = tid & 7, tp = tid >> 3;
#pragma unroll
    for (int rr = 0; rr < 5; ++rr) { const int t = t0 + 2 * tp - 3 + rr; P.x[rr] = (u32x4){0u, 0u, 0u, 0u}; if (t >= 0) P.x[rr] = *(const u32x4*)(zb + (size_t)t * INC + LX0 + c0 + 8 * cg8); }
#pragma unroll
    for (int i = 0; i < 2; ++i) { const int idx = tid + 512 * i; const int row = idx >> 3, ch = idx & 7;
        P.g[i] = *(const u32x4*)(zb + (size_t)(t0 + row) * INC + LG0 + c0 + ch * 8); }
}
__device__ __forceinline__ void lru_chain(unsigned char* ws_, const float* const* in_, int l_, LAS unsigned char* lds, int tid, int bid, int G) {
    const MixCtx X = mk_mix(ws_, in_, l_); tid = launder_v(tid);
    const int lane = tid & 63, w = __builtin_amdgcn_readfirstlane(tid >> 6); const int l = X.l;
    LAS unsigned char* UB = lds + LR_UB; LAS float* A_ = (LAS float*)(lds + LR_A); LAS float* B_ = (LAS float*)(lds + LR_B);
    LAS unsigned char* WT = lds + LR_WT; LAS float* PRM = (LAS float*)(lds + LR_PRM); LAS float* SA = (LAS float*)(lds + LR_SA); LAS float* SB = (LAS float*)(lds + LR_SB); LAS unsigned char* GT = lds + LR_GT;
    LAS float* CAR = (LAS float*)(lds + LR_CAR);
    const int cg8 = tid & 7, tp = tid >> 3; const int j = lane & 15, kq = lane >> 4;
    for (int chain = bid; chain < BATCH * 6; chain += G) {
        const int b = chain / 6, h = chain % 6, c0 = h * 64;
        LruPre P; lru_load(X, b, h, 0, tid, P);
        f32x4 cwv[4][2], cbv[2];
#pragma unroll
        for (int e2 = 0; e2 < 2; ++e2) { cbv[e2] = *(const f32x4*)(gptr(X.in[8]) + l * LW + c0 + 8 * cg8 + 4 * e2);
#pragma unroll
            for (int k = 0; k < 4; ++k) cwv[k][e2] = *(const f32x4*)(gptr(X.in[7]) + (size_t)(l * 4 + k) * LW + c0 + 8 * cg8 + 4 * e2); }
        __syncthreads();
#pragma unroll
        for (int i = 0; i < 2; ++i) { const int idx = tid + 512 * i; const int row = idx >> 3, ch = idx & 7;
            *(LAS u32x4*)(WT + row * 144 + ch * 16) = *(const u32x4*)(X.WTG + (size_t)(l * 6 + h) * 8192 + idx * 8); }
        if (tid < 64) { PRM[tid] = gptr(X.in[10])[l * LW + c0 + tid]; PRM[64 + tid] = gptr(X.in[12])[l * LW + c0 + tid]; PRM[128 + tid] = log1pf(__expf(-gptr(X.in[13])[l * LW + c0 + tid])); CAR[tid] = 0.f; }
        LAS unsigned char* OT = lds + LR_A;
        for (int chunk = 0; chunk < 16; ++chunk) {
            const int t0 = chunk * 128;
            if (chunk > 0) {
#pragma unroll
                for (int i = 0; i < 2; ++i) { const int idx = tid + 512 * i; const int row = idx >> 3, ch = idx & 7;
                    *(u32x4*)(X.MIX + ((size_t)b * SEQ + t0 - 128 + row) * DM + AW + CW + c0 + ch * 8) = *(const LAS u32x4*)(OT + row * 144 + ch * 16); }
            }
#pragma unroll
            for (int i = 0; i < 2; ++i) { const int idx = tid + 512 * i; const int row = idx >> 3, ch = idx & 7; *(LAS u32x4*)(GT + row * 144 + ch * 16) = P.g[i]; }
            { f32x4 xv[5][2];
#pragma unroll
              for (int rr = 0; rr < 5; ++rr) { const u32x4 v = P.x[rr]; xv[rr][0] = (f32x4){bf_lo(v.x), bf_hi(v.x), bf_lo(v.y), bf_hi(v.y)}; xv[rr][1] = (f32x4){bf_lo(v.z), bf_hi(v.z), bf_lo(v.w), bf_hi(v.w)}; }
#pragma unroll
              for (int tk = 0; tk < 2; ++tk) { f32x4 u0 = cbv[0], u1 = cbv[1];
#pragma unroll
                  for (int k = 0; k < 4; ++k) { u0 += cwv[k][0] * xv[tk + k][0]; u1 += cwv[k][1] * xv[tk + k][1]; }
                  const int tok = 2 * tp + tk;
                  u32x4 pw; pw.x = cvt_pk_bf16(u0[0], u0[1]); pw.y = cvt_pk_bf16(u0[2], u0[3]); pw.z = cvt_pk_bf16(u1[0], u1[1]); pw.w = cvt_pk_bf16(u1[2], u1[3]);
                  *(LAS u32x4*)(UB + tok * 144 + cg8 * 16) = pw;
                  *(LAS f32x4*)(B_ + tok * 68 + cg8 * 8) = u0; *(LAS f32x4*)(B_ + tok * 68 + cg8 * 8 + 4) = u1; } }
            __syncthreads();
            if (chunk < 15) lru_load(X, b, h, chunk + 1, tid, P);
            { const int tok = 16 * w + j; bf16x8 bfr[2];
#pragma unroll
              for (int c = 0; c < 2; ++c) bfr[c] = *(const LAS bf16x8*)(UB + tok * 144 + kq * 16 + c * 64);
#pragma unroll
              for (int ot = 0; ot < 4; ++ot) { f32x4 da = (f32x4){0.f, 0.f, 0.f, 0.f}, dx = da;
#pragma unroll
                  for (int c = 0; c < 2; ++c) { const bf16x8 fa = *(const LAS bf16x8*)(WT + (16 * ot + j) * 144 + kq * 16 + c * 64), fx = *(const LAS bf16x8*)(WT + (64 + 16 * ot + j) * 144 + kq * 16 + c * 64);
                      da = __builtin_amdgcn_mfma_f32_16x16x32_bf16(fa, bfr[c], da, 0, 0, 0); dx = __builtin_amdgcn_mfma_f32_16x16x32_bf16(fx, bfr[c], dx, 0, 0, 0); }
                  const int ch = 16 * ot + 4 * kq;
                  const f32x4 ba4 = *(const LAS f32x4*)(PRM + ch), bx4 = *(const LAS f32x4*)(PRM + 64 + ch), sp4 = *(const LAS f32x4*)(PRM + 128 + ch);
                  const f32x4 u4 = *(const LAS f32x4*)(B_ + tok * 68 + ch); f32x4 a4, b4;
#pragma unroll
                  for (int e = 0; e < 4; ++e) { const float rg = sigmoidf_(da[e] + ba4[e]), ig = sigmoidf_(dx[e] + bx4[e]); const float la = -8.0f * rg * sp4[e];
                      const float av_ = __expf(la); a4[e] = av_; b4[e] = sqrtf(fmaxf(1.0f - av_ * av_, 0.f)) * ig * u4[e]; }
                  *(LAS f32x4*)(A_ + tok * 68 + ch) = a4; *(LAS f32x4*)(B_ + tok * 68 + ch) = b4; } }
            __syncthreads();
            float av[16], bv[16]; float hh = 0.f, aa = 1.f;
#pragma unroll
            for (int i = 0; i < 16; ++i) { av[i] = A_[(16 * w + i) * 68 + lane]; bv[i] = B_[(16 * w + i) * 68 + lane]; hh = av[i] * hh + bv[i]; aa *= av[i]; }
            SA[w * 64 + lane] = aa; SB[w * 64 + lane] = hh;
            __syncthreads();
            float hin = CAR[(chunk & 1) * 64 + lane];
            for (int sgi = 0; sgi < w; ++sgi) hin = SA[sgi * 64 + lane] * hin + SB[sgi * 64 + lane];
            hh = hin;
#pragma unroll
            for (int i = 0; i < 16; i += 2) { hh = av[i] * hh + bv[i]; const float h0 = hh; hh = av[i + 1] * hh + bv[i + 1]; const int tl = 16 * w + i;
                const float g0 = gelu_tanh(bf2f(*(const LAS bf16_t*)(GT + tl * 144 + lane * 2))), g1 = gelu_tanh(bf2f(*(const LAS bf16_t*)(GT + (tl + 1) * 144 + lane * 2)));
                const unsigned pk = cvt_pk_bf16(g0 * h0, g1 * hh);
                *(LAS bf16_t*)(OT + tl * 144 + lane * 2) = (bf16_t)(pk & 0xffffu); *(LAS bf16_t*)(OT + (tl + 1) * 144 + lane * 2) = (bf16_t)(pk >> 16); }
            if (w == 7) CAR[((chunk + 1) & 1) * 64 + lane] = hh;
            __syncthreads();
        }
#pragma unroll
        for (int i = 0; i < 2; ++i) { const int idx = tid + 512 * i; const int row = idx >> 3, ch = idx & 7;
            *(u32x4*)(X.MIX + ((size_t)b * SEQ + 15 * 128 + row) * DM + AW + CW + c0 + ch * 8) = *(const LAS u32x4*)(OT + row * 144 + ch * 16); }
    }
}

__device__ __forceinline__ void mixer_phase(const Ctx& C, int l) {
    lru_chain(C.ws, C.in, l, C.lds, C.tid, C.bid, C.G);
    int a_start, a_cnt, a_stride;
    if (C.G == 256) { if (C.bid >= 192) { a_start = (C.bid - 192) * 27; a_cnt = 27; } else { a_start = 64 * 27 + C.bid * 7; a_cnt = 7; } a_stride = 1; }
    else { a_start = C.bid; a_stride = C.G; a_cnt = (N_ATT - C.bid + C.G - 1) / C.G; }
    attn_loop(C.ws, C.in, l, C.lds, C.tid, a_start, a_cnt, a_stride);
    conv_loop(C.ws, C.in, l, C.lds, C.tid, C.bid, C.G);
}

__device__ __forceinline__ void alpha_phase(const Ctx& C) {
    const bf16_t* AO = (const bf16_t*)(C.ws + WS_AO); bf16_t* MIX = (bf16_t*)(C.ws + WS_MIX); const float* LSE = (const float*)(C.ws + WS_LSE);
    const int gw = C.bid * 8 + C.wave, NGW = C.G * 8;
    for (int tg = gw; tg < M / 4; tg += NGW) {
#pragma unroll
        for (int i = 0; i < 3; ++i) { const int L = C.lane + 64 * i; const size_t tok = (size_t)4 * tg + L / 48; const int ch = L % 48, h = ch >> 3, jj = h & 1, g = h >> 1;
            const float l0 = LSE[tok * 6 + jj], l1 = LSE[tok * 6 + 2 + jj], l2 = LSE[tok * 6 + 4 + jj];
            const float mx = fmaxf(l0, fmaxf(l1, l2)); const float e0 = __expf(l0 - mx), e1 = __expf(l1 - mx), e2 = __expf(l2 - mx);
            const float al = (g == 0 ? e0 : (g == 1 ? e1 : e2)) / (e0 + e1 + e2);
            const u32x4 v = *(const u32x4*)(AO + tok * AW + ch * 8); u32x4 o;
            o.x = pk2(bf_lo(v.x) * al, bf_hi(v.x) * al); o.y = pk2(bf_lo(v.y) * al, bf_hi(v.y) * al); o.z = pk2(bf_lo(v.z) * al, bf_hi(v.z) * al); o.w = pk2(bf_lo(v.w) * al, bf_hi(v.w) * al);
            *(u32x4*)(MIX + tok * DM + ch * 8) = o; }
    }
}

__device__ __forceinline__ void final_phase(const Ctx& C) {
    const u64* ssq = (const u64*)(C.ws + WS_SSQ) + 4 * (size_t)M; const float* g = gptr(C.in[18]);
    const int gw = C.bid * 8 + C.wave, NGW = C.G * 8;
    f32x4 gv[4];
#pragma unroll
    for (int j = 0; j < 4; ++j) gv[j] = *((const f32x4*)g + C.lane + 64 * j);
    const bf16_t* XB = (const bf16_t*)(C.ws + WS_XB);
    for (int m0 = gw * 4; m0 < M; m0 += NGW * 4) {
        u32x2 v[4][4]; float ri[4];
#pragma unroll
        for (int r = 0; r < 4; ++r) { ri[r] = rinv_from(__hip_atomic_load(ssq + m0 + r, __ATOMIC_RELAXED, __HIP_MEMORY_SCOPE_AGENT)); const u32x2* xi = (const u32x2*)(XB + (size_t)(m0 + r) * DM) + C.lane;
#pragma unroll
            for (int j = 0; j < 4; ++j) v[r][j] = xi[64 * j]; }
#pragma unroll
        for (int r = 0; r < 4; ++r) { f32x4* xr = (f32x4*)(C.out + (size_t)(m0 + r) * DM) + C.lane;
#pragma unroll
            for (int j = 0; j < 4; ++j) __builtin_nontemporal_store((f32x4){bf_lo(v[r][j].x), bf_hi(v[r][j].x), bf_lo(v[r][j].y), bf_hi(v[r][j].y)} * ri[r] * gv[j], xr + 64 * j); }
    }
}

constexpr int N_PHASES = 14;
__global__ void __launch_bounds__(512, 2) fwd_kernel(Args args) {
    extern __shared__ __attribute__((aligned(16))) unsigned char lds_raw[];
#define IN(k) (true)
#define MKCTX Ctx C; C.in = args.in; C.out = (float*)launder((unsigned char*)args.out); C.ws = launder(args.ws); C.lds = (LAS unsigned char*)lds_raw; \
    C.tid = launder_v((int)threadIdx.x); C.lane = C.tid & 63; C.wave = __builtin_amdgcn_readfirstlane(C.tid >> 6); C.G = gridDim.x; C.bid = blockIdx.x;
    LAS unsigned char* const ldsp = (LAS unsigned char*)lds_raw; const int G_ = gridDim.x, bid_ = blockIdx.x;
#define SYNC(k) do { xcd_barrier(xbar); } while (0)
    { volatile LAS unsigned* misc = (volatile LAS unsigned*)(lds_raw + MISC_OFF); if (threadIdx.x < 16) misc[threadIdx.x] = 0u; __syncthreads(); }
    if (IN(0)) { MKCTX; prologue(C); }
    cg::this_grid().sync();
    XcdBarrier xbar = xcd_barrier_post((unsigned*)(args.ws + WS_BAR), (volatile LAS unsigned*)((LAS unsigned char*)lds_raw + MISC_OFF + 32));
    for (int l = 0; l < 2; ++l) {
        asm volatile("" : "+s"(l));
        const int pb = 1 + 6 * l;
        if (IN(pb)) {
            unsigned char* ws = launder(args.ws); unsigned char* wb = ws + WS_W + l * W_LAYER;
            pg8::Gemm g{(const bf16_t*)(ws + WS_XB), (const bf16_t*)(wb + WO_IN), M, INP, DM}; pg8::StaticOrder S; S.init(M, INP, G_, bid_);
            pg8::EpiRowScale<0> E{(bf16_t*)(ws + WS_Z), INC, (const u64*)(ws + WS_SSQ) + (size_t)(2 * l) * M, INC, ldsp + EPI_STG_OFF};
            pg8::gemm_phase<pg8::EpiRowScale<0>, pg8::StaticOrder, true, true>(ldsp, g, S, E);
        }
        SYNC(pb);
        if (IN(pb + 1)) { MKCTX; mixer_phase(C, l); }
        SYNC(pb + 1);
        if (IN(pb + 2)) { MKCTX; alpha_phase(C); }
        SYNC(pb + 2);
        if (IN(pb + 3)) {
            unsigned char* ws = launder(args.ws); unsigned char* wb = ws + WS_W + l * W_LAYER;
            pg8::Gemm g{(const bf16_t*)(ws + WS_MIX), (const bf16_t*)(wb + WO_OUT), M, DM, DM}; pg8::StaticOrder S; S.init(M, DM, G_, bid_);
            pg8::EpiResid E{(bf16_t*)(ws + WS_XB), (u64*)(ws + WS_SSQ) + (size_t)(2 * l + 1) * M, ldsp + EPI_STG_OFF};
            pg8::gemm_phase<pg8::EpiResid, pg8::StaticOrder, true, true>(ldsp, g, S, E);
        }
        SYNC(pb + 3);
        if (IN(pb + 4)) {
            unsigned char* ws = launder(args.ws); unsigned char* wb = ws + WS_W + l * W_LAYER;
            pg8::Gemm g{(const bf16_t*)(ws + WS_XB), (const bf16_t*)(wb + WO_UP), M, FF, DM}; pg8::StaticOrder S; S.init(M, FF, G_, bid_);
            pg8::EpiRowScale<1> E{(bf16_t*)(ws + WS_BIG), FF, (const u64*)(ws + WS_SSQ) + (size_t)(2 * l + 1) * M, FF, ldsp + EPI_STG_OFF};
            pg8::gemm_phase<pg8::EpiRowScale<1>, pg8::StaticOrder, true, true>(ldsp, g, S, E);
        }
        SYNC(pb + 4);
        if (IN(pb + 5)) {
            unsigned char* ws = launder(args.ws); unsigned char* wb = ws + WS_W + l * W_LAYER;
            pg8::Gemm g{(const bf16_t*)(ws + WS_BIG), (const bf16_t*)(wb + WO_DN), M, DM, FF}; pg8::StaticOrder S; S.init(M, DM, G_, bid_);
            pg8::EpiResid E{(bf16_t*)(ws + WS_XB), (u64*)(ws + WS_SSQ) + (size_t)(2 * l + 2) * M, ldsp + EPI_STG_OFF};
            pg8::gemm_phase<pg8::EpiResid, pg8::StaticOrder, true, true>(ldsp, g, S, E);
        }
        SYNC(pb + 5);
    }
    if (IN(13)) { MKCTX; final_phase(C); }
#undef IN
#undef SYNC
#undef MKCTX
}

extern "C" void kernel_launch(void* const* d_in, const int* in_sizes, int n_in, void* d_out, int out_size, void* d_ws, size_t ws_size, hipStream_t stream) {
    static int grid = 0;
    if (grid == 0) {
        if (n_in != 19 || in_sizes[0] != M * DM || out_size != M * DM || ws_size < WS_END) { fprintf(stderr, "kernel_launch: unexpected shapes (n_in %d, in0 %d, out %d, ws %zu)\n", n_in, n_in > 0 ? in_sizes[0] : -1, out_size, ws_size); grid = -1; return; }
        int dev = 0, cus = 0, per_cu = 0;
        if (hipGetDevice(&dev) != hipSuccess || hipDeviceGetAttribute(&cus, hipDeviceAttributeMultiprocessorCount, dev) != hipSuccess) { grid = -1; return; }
        if (hipFuncSetAttribute((const void*)fwd_kernel, hipFuncAttributeMaxDynamicSharedMemorySize, LDS_BYTES) != hipSuccess) { fprintf(stderr, "kernel_launch: hipFuncSetAttribute failed\n"); grid = -1; return; }
        if (hipOccupancyMaxActiveBlocksPerMultiprocessor(&per_cu, (const void*)fwd_kernel, 512, LDS_BYTES) != hipSuccess || per_cu < 1) { fprintf(stderr, "kernel_launch: occupancy query says %d\n", per_cu); per_cu = 1; }
        (void)hipGetLastError();
        grid = cus * per_cu;
    }
    if (grid < 0) return;
    Args a{};
    for (int i = 0; i < 19; ++i) a.in[i] = (const float*)d_in[i];
    a.out = (float*)d_out; a.ws = (unsigned char*)d_ws;
#if ONE_LAUNCH
    a.ph_lo = 0; a.ph_hi = N_PHASES;
    void* kargs[] = {&a};
    hipError_t e = hipLaunchCooperativeKernel((const void*)fwd_kernel, dim3(grid), dim3(512), kargs, LDS_BYTES, stream);
    if (e != hipSuccess) fprintf(stderr, "cooperative launch failed: %s (grid %d)\n", hipGetErrorString(e), grid);
#else
    for (int p = 0; p < N_PHASES; ++p) { a.ph_lo = p; a.ph_hi = p + 1; hipLaunchKernelGGL(fwd_kernel, dim3(grid), dim3(512), LDS_BYTES, stream, a); }
#endif
}
```
